# Optimizing an MI355X kernel written in HIP

```python
import math
import jax, jax.numpy as jnp
from jax import lax
import numpy as np

D_MODEL = 1024
BATCH = 4
SEQ = 8192
DEPTH = 1
DEC_BATCH = 128
DEC_SEQ = 4
PAST_LEN = 8192
PAGE_SIZE = 128

DN_HEADS = 4
DN_DK = 128
DN_DV = 128
QK_W = DN_HEADS * DN_DK
DN_WIDTH = DN_HEADS * DN_DV
CONV_W = 4
CONV_CH = 2 * QK_W + DN_WIDTH
DN_CHUNK = 64
SW_HEADS = 8
SW_HD = 64
SW_WIDTH = SW_HEADS * SW_HD
DILATIONS = ((128, 1), (512, 4), (2048, 16))
WIN_MAX = 2048
D_MIX = DN_WIDTH + SW_WIDTH
D_IN = CONV_CH + DN_WIDTH + 2 * DN_HEADS + 3 * SW_WIDTH + SW_WIDTH
NORM_EPS = 1e-6

kernel_name = 'hymba_gdn_dilated_swa_step'


def rmsnorm(x, g):
    xf = x.astype(jnp.float32)
    xf = xf * lax.rsqrt(jnp.mean(xf * xf, axis=-1, keepdims=True) + NORM_EPS)
    return xf.astype(x.dtype) * g


def l2normalize(x):
    xf = x.astype(jnp.float32)
    return xf * lax.rsqrt(jnp.sum(xf * xf, axis=-1, keepdims=True) + NORM_EPS)


def causal_short_conv(x_ext, w):
    L = x_ext.shape[1] - (CONV_W - 1)
    y = w[0] * x_ext[:, 0:L]
    for j in range(1, CONV_W):
        y = y + w[j] * x_ext[:, j:j + L]
    return jax.nn.silu(y)


def gated_delta_rule(q, k, v, g, beta, s0):
    B_, L, H, _ = q.shape
    dv = v.shape[-1]
    C = min(DN_CHUNK, L)
    n = -(-L // C)
    pad = n * C - L
    f32 = jnp.float32

    def blocks(t):
        t = jnp.pad(t.astype(f32), [(0, 0), (0, pad)] + [(0, 0)] * (t.ndim - 2))
        t = jnp.moveaxis(t, 1, 2)
        return t.reshape(t.shape[:2] + (n, C) + t.shape[3:])

    q, k, v, g, beta = (blocks(t) for t in (q, k, v, g, beta))
    gc = jnp.cumsum(g, axis=-1)
    incl = jnp.tril(jnp.ones((C, C), dtype=bool))
    strict = jnp.tril(jnp.ones((C, C), dtype=bool), -1)
    decay = jnp.exp(jnp.where(incl, gc[..., :, None] - gc[..., None, :], -jnp.inf))
    kb = k * beta[..., None]
    a_mat = jnp.where(strict, jnp.einsum('bhnid,bhnjd->bhnij', kb, k) * decay, 0.0)
    rhs = jnp.concatenate([v * beta[..., None], kb * jnp.exp(gc)[..., None]], axis=-1)
    sol = lax.linalg.triangular_solve(jnp.eye(C, dtype=f32) + a_mat, rhs,
                                      left_side=True, lower=True, unit_diagonal=True)
    u, w = sol[..., :dv], sol[..., dv:]
    attn = jnp.einsum('bhnid,bhnjd->bhnij', q, k) * decay
    q_dec = q * jnp.exp(gc)[..., None]
    k_dec = k * jnp.exp(gc[..., -1:] - gc)[..., None]
    g_last = jnp.exp(gc[..., -1])

    def step(S, xs):
        u_c, w_c, q_c, k_c, a_c, gl = xs
        v_new = u_c - jnp.einsum('bhck,bhkv->bhcv', w_c, S)
        o_c = jnp.einsum('bhck,bhkv->bhcv', q_c, S) + jnp.einsum('bhij,bhjv->bhiv', a_c, v_new)
        S = S * gl[..., None, None] + jnp.einsum('bhck,bhcv->bhkv', k_c, v_new)
        return S, o_c

    xs = tuple(jnp.moveaxis(t, 2, 0) for t in (u, w, q_dec, k_dec, attn, g_last))
    S, o = lax.scan(step, s0.astype(f32), xs)
    o = jnp.moveaxis(o, 0, 2).reshape(B_, H, n * C, dv)[:, :, :L]
    return jnp.moveaxis(o, 2, 1), S


def banded_window_attn(q, k, v, steps):
    N, n, H, hd = q.shape
    blk = steps
    nb = -(-n // blk)
    pad = nb * blk - n
    f32 = jnp.float32

    def to_blocks(t):
        t = jnp.pad(t, ((0, 0), (0, pad), (0, 0), (0, 0)))
        return t.reshape(N, nb, blk, H, hd)

    qb, kb, vb = to_blocks(q), to_blocks(k), to_blocks(v)
    prev = lambda t: jnp.pad(t, ((0, 0), (1, 0), (0, 0), (0, 0), (0, 0)))[:, :-1]
    kk = jnp.concatenate([prev(kb), kb], axis=2)
    vv = jnp.concatenate([prev(vb), vb], axis=2)
    s = jnp.einsum('ncqhd,nckhd->nchqk', qb, kk).astype(f32) * (hd ** -0.5)
    qi = jnp.arange(blk)[:, None]
    kj = jnp.arange(2 * blk)[None, :]
    band = (kj >= blk + qi - steps) & (kj <= blk + qi)
    has_prev = (jnp.arange(nb) > 0)[:, None, None] | (kj >= blk)[None]
    mask = band[None] & has_prev
    s = jnp.where(mask[None, :, None], s, -jnp.inf)
    m = jnp.max(s, axis=-1)
    p = jnp.exp(s - m[..., None])
    l = jnp.sum(p, axis=-1)
    num = jnp.einsum('nchqk,nckhd->ncqhd', p, vv.astype(f32)).reshape(N, nb * blk, H, hd)[:, :n]
    m = jnp.moveaxis(m, 2, 3).reshape(N, nb * blk, H)[:, :n]
    l = jnp.moveaxis(l, 2, 3).reshape(N, nb * blk, H)[:, :n]
    return num, m, l


def dilated_branch_prompt(q, k, v, steps, d):
    B_, S_, H, hd = q.shape
    n = S_ // d
    to_sub = lambda t: t.reshape(B_, n, d, H, hd).transpose(0, 2, 1, 3, 4).reshape(B_ * d, n, H, hd)
    num, m, l = banded_window_attn(to_sub(q), to_sub(k), to_sub(v), steps)
    num = num.reshape(B_, d, n, H, hd).transpose(0, 2, 1, 3, 4).reshape(B_, S_, H, hd)
    m = m.reshape(B_, d, n, H).transpose(0, 2, 1, 3).reshape(B_, S_, H)
    l = l.reshape(B_, d, n, H).transpose(0, 2, 1, 3).reshape(B_, S_, H)
    return num, m, l


def dilated_branch_sample(q, k_ext, v_ext, steps, d):
    T = q.shape[1]
    hd = q.shape[-1]
    lbuf = k_ext.shape[1] - T
    idx = lbuf + jnp.arange(T)[:, None] - d * jnp.arange(steps + 1)[None, :]
    valid = idx >= 0
    idx = jnp.maximum(idx, 0)
    kg = jnp.take(k_ext, idx, axis=1)
    vg = jnp.take(v_ext, idx, axis=1)
    s = jnp.einsum('bthd,btjhd->bthj', q, kg).astype(jnp.float32) * (hd ** -0.5)
    s = jnp.where(valid[None, :, None, :], s, -jnp.inf)
    m = jnp.max(s, axis=-1)
    p = jnp.exp(s - m[..., None])
    l = jnp.sum(p, axis=-1)
    num = jnp.einsum('bthj,btjhd->bthd', p, vg.astype(jnp.float32))
    return num, m, l


def merge_dilations(parts):
    ms = jnp.stack([m for _, m, _ in parts])
    mx = jnp.max(ms, axis=0)
    wts = jnp.exp(ms - mx)
    num = sum(wts[i][..., None] * parts[i][0] for i in range(len(parts)))
    den = sum(wts[i] * parts[i][2] for i in range(len(parts)))
    return num / den[..., None]


def hybrid_layer(x, conv_prefix, s0, k_win, v_win, norm_g, w_in, conv_w, a_log, dt_bias, dn_norm_g, w_out):
    B_, L, _ = x.shape
    f32 = jnp.float32
    h = rmsnorm(x, norm_g)
    proj = jnp.einsum('bld,de->ble', h, w_in)
    o0 = CONV_CH
    o1 = o0 + DN_WIDTH
    o2 = o1 + DN_HEADS
    o3 = o2 + DN_HEADS
    o4 = o3 + 3 * SW_WIDTH
    qkv_raw, z_a, a_in, b_in = proj[..., :o0], proj[..., o0:o1], proj[..., o1:o2], proj[..., o2:o3]
    qkv_b, z_b = proj[..., o3:o4], proj[..., o4:]

    x_ext = jnp.concatenate([conv_prefix.astype(x.dtype), qkv_raw], axis=1)
    qkv = causal_short_conv(x_ext, conv_w)
    new_conv = x_ext[:, -(CONV_W - 1):]
    qa, ka, va = jnp.split(qkv, [QK_W, 2 * QK_W], axis=-1)
    qa = l2normalize(qa.reshape(B_, L, DN_HEADS, DN_DK)) * (DN_DK ** -0.5)
    ka = l2normalize(ka.reshape(B_, L, DN_HEADS, DN_DK))
    va = va.reshape(B_, L, DN_HEADS, DN_DV)
    g = -jnp.exp(a_log.astype(f32)) * jax.nn.softplus(a_in.astype(f32) + dt_bias.astype(f32))
    beta = jax.nn.sigmoid(b_in.astype(f32))
    o_a, s_new = gated_delta_rule(qa, ka, va, g, beta, s0)
    o_a = rmsnorm(o_a.astype(x.dtype), dn_norm_g) * jax.nn.silu(z_a.reshape(B_, L, DN_HEADS, DN_DV))

    qb, kb, vb = (t.reshape(B_, L, SW_HEADS, SW_HD) for t in jnp.split(qkv_b, 3, axis=-1))
    if k_win is None:
        parts = [dilated_branch_prompt(qb, kb, vb, w // d, d) for w, d in DILATIONS]
        keep = min(WIN_MAX, L)
        new_k, new_v = kb[:, L - keep:], vb[:, L - keep:]
    else:
        k_ext = jnp.concatenate([k_win.astype(x.dtype), kb], axis=1)
        v_ext = jnp.concatenate([v_win.astype(x.dtype), vb], axis=1)
        parts = [dilated_branch_sample(qb, k_ext, v_ext, w // d, d) for w, d in DILATIONS]
        keep = k_win.shape[1]
        new_k, new_v = k_ext[:, -keep:], v_ext[:, -keep:]
    o_b = merge_dilations(parts).astype(x.dtype) * jax.nn.silu(z_b.reshape(B_, L, SW_HEADS, SW_HD))

    mix = jnp.concatenate([o_a.reshape(B_, L, DN_WIDTH), o_b.reshape(B_, L, SW_WIDTH)], axis=-1)
    y = x + jnp.einsum('ble,ed->bld', mix, w_out)
    return y, new_conv, s_new.astype(x.dtype), new_k, new_v


def setup_inputs(seed: int = 0) -> dict:
    key = jax.random.key(seed)
    ks = jax.random.split(key, 16)
    lbuf = min(WIN_MAX, PAST_LEN)
    nrm = jax.random.normal
    x_prompt = nrm(ks[0], (BATCH, SEQ, D_MODEL), jnp.float32)
    x_sample = nrm(ks[1], (DEC_BATCH, DEC_SEQ, D_MODEL), jnp.float32)
    state_conv = nrm(ks[2], (DEPTH, DEC_BATCH, CONV_W - 1, CONV_CH), jnp.float32)
    state_delta = 0.1 * nrm(ks[3], (DEPTH, DEC_BATCH, DN_HEADS, DN_DK, DN_DV), jnp.float32)
    cache_k_win = nrm(ks[4], (DEPTH, DEC_BATCH, lbuf, SW_HEADS, SW_HD), jnp.float32)
    cache_v_win = nrm(ks[5], (DEPTH, DEC_BATCH, lbuf, SW_HEADS, SW_HD), jnp.float32)
    norm_g = 1.0 + 0.01 * nrm(ks[6], (DEPTH, D_MODEL), jnp.float32)
    final_norm_g = 1.0 + 0.01 * nrm(ks[7], (D_MODEL,), jnp.float32)
    w_in = nrm(ks[8], (DEPTH, D_MODEL, D_IN), jnp.float32) * (D_MODEL ** -0.5)
    conv_w = nrm(ks[9], (DEPTH, CONV_W, CONV_CH), jnp.float32) * (CONV_W ** -0.5)
    a_log = jnp.log(jax.random.uniform(ks[10], (DEPTH, DN_HEADS), jnp.float32, 1.0, 16.0))
    dt = jnp.exp(jax.random.uniform(ks[11], (DEPTH, DN_HEADS), jnp.float32, math.log(1e-3), math.log(1e-1)))
    dt_bias = dt + jnp.log(-jnp.expm1(-dt))
    dn_norm_g = 1.0 + 0.01 * nrm(ks[12], (DEPTH, DN_DV), jnp.float32)
    w_out = nrm(ks[13], (DEPTH, D_MIX, D_MODEL), jnp.float32) * (D_MIX ** -0.5)
    return {'x_prompt': x_prompt, 'x_sample': x_sample, 'state_conv': state_conv,
            'state_delta': state_delta, 'cache_k_win': cache_k_win, 'cache_v_win': cache_v_win,
            'norm_g': norm_g, 'final_norm_g': final_norm_g, 'w_in': w_in, 'conv_w': conv_w,
            'a_log': a_log, 'dt_bias': dt_bias, 'dn_norm_g': dn_norm_g, 'w_out': w_out}


def reference(x_prompt, x_sample, state_conv, state_delta, cache_k_win, cache_v_win,
              norm_g, final_norm_g, w_in, conv_w, a_log, dt_bias, dn_norm_g, w_out):
    yp, ys = x_prompt, x_sample
    bp = x_prompt.shape[0]
    p_conv, p_delta, p_k, p_v = [], [], [], []
    s_conv, s_delta, s_k, s_v = [], [], [], []
    for l in range(DEPTH):
        weights = (norm_g[l], w_in[l], conv_w[l], a_log[l], dt_bias[l], dn_norm_g[l], w_out[l])
        zero_conv = jnp.zeros((bp, CONV_W - 1, CONV_CH), x_prompt.dtype)
        zero_state = jnp.zeros((bp, DN_HEADS, DN_DK, DN_DV), jnp.float32)
        yp, c, s, k, v = hybrid_layer(yp, zero_conv, zero_state, None, None, *weights)
        p_conv.append(c); p_delta.append(s); p_k.append(k); p_v.append(v)
        ys, c, s, k, v = hybrid_layer(ys, state_conv[l], state_delta[l], cache_k_win[l], cache_v_win[l], *weights)
        s_conv.append(c); s_delta.append(s); s_k.append(k); s_v.append(v)
    y_prompt = rmsnorm(yp, final_norm_g)
    y_sample = rmsnorm(ys, final_norm_g)
    new_conv_prompt = jnp.stack(p_conv)
    new_delta_prompt = jnp.stack(p_delta)
    new_k_win_prompt = jnp.stack(p_k)
    new_v_win_prompt = jnp.stack(p_v)
    new_conv_sample = jnp.stack(s_conv)
    new_delta_sample = jnp.stack(s_delta)
    new_k_win_sample = jnp.stack(s_k)
    new_v_win_sample = jnp.stack(s_v)
    return (y_prompt, y_sample, new_conv_prompt, new_delta_prompt, new_k_win_prompt, new_v_win_prompt,
            new_conv_sample, new_delta_sample, new_k_win_sample, new_v_win_sample)
```

```cpp
#include <hip/hip_runtime.h>
#include <cstdio>
#include <cstdint>
namespace pg8 {
#define PG8_LAS __attribute__((address_space(3)))
typedef unsigned short bf16_t;
typedef short bf16x8 __attribute__((ext_vector_type(8)));
typedef float f32x4 __attribute__((ext_vector_type(4)));
typedef unsigned u32x4 __attribute__((ext_vector_type(4)));
constexpr int BM = 256, BK = 64, HALF = 128, HTB = HALF * BK * 2  , STAGE_BYTES = 8 * HTB, NXCD = 8, WGM = 8;

__host__ __device__ __forceinline__ int lds_byte(int r, int c) { const int st = (r >> 4) * 2 + (c >> 5), rr = r & 15, cc = c & 31, ob = rr * 64 + cc * 2; return st * 1024 + (ob ^ (((ob >> 9) & 1) << 5)); }
__host__ __device__ __forceinline__ void stage_rc(int b, int& R, int& C) { const int st = b / 1024, sb = b % 1024, swz = sb ^ (((sb >> 9) & 1) << 5); R = (st >> 1) * 16 + swz / 64; C = (st & 1) * 32 + (swz % 64) / 2; }
__host__ __device__ __forceinline__ int perm32(int rho) { const int n = rho >> 4, i = rho & 15; return 8 * (i >> 2) + 4 * n + (i & 3); }

struct Unit { int pm, pn; };
struct Gemm { const bf16_t* A; const bf16_t* Bt; int M, N, K; };

struct StaticOrder {
    int nM, nN, nwg, G, c;
    __host__ __device__ void init(int M, int N, int G_, int c_) { nM = M / BM; nN = N / BM; nwg = nM * nN; G = G_; c = c_; }
    __host__ __device__ bool next(int i, Unit& u) const {
        const long L = (long)i * G + c; if (L >= nwg) return false;
        int wgid = (int)L; { const int q = nwg / NXCD, r = nwg % NXCD, xcd = wgid % NXCD, off = wgid / NXCD; wgid = (xcd < r ? xcd * (q + 1) : r * (q + 1) + (xcd - r) * q) + off; }
        const int nig = WGM * nN, gid = wgid / nig, fm = gid * WGM, gsz = (nM - fm) < WGM ? (nM - fm) : WGM;
        u.pm = fm + ((wgid % nig) % gsz); u.pn = (wgid % nig) / gsz; return true;
    }
    __device__ __forceinline__ void a_ready(const Unit&) const {}
    __device__ __forceinline__ void done(const Unit&) const {}
};

__device__ __forceinline__ unsigned cvt_pk_bf16(float lo, float hi) { unsigned r; asm volatile("v_cvt_pk_bf16_f32 %0, %1, %2" : "=v"(r) : "v"(lo), "v"(hi)); return r; }
typedef float f32x2 __attribute__((ext_vector_type(2)));
struct EpiBf16 {
    static constexpr bool PERM = true, AFTER_DRAIN = false;
    bf16_t* O; int ldc;
    __device__ __forceinline__ void operator()(const f32x4 (&acc)[2][2][4][2], const Unit& u, int wr, int wc, int fr, int fq) const {
        const int row0 = u.pm * BM + wr * 64 + fr; const int col0 = u.pn * BM + wc * 32 + 8 * fq;
#pragma unroll
        for (int ai = 0; ai < 2; ++ai)
#pragma unroll
            for (int m = 0; m < 4; ++m) { bf16_t* rowp = O + (size_t)(row0 + ai * HALF + m * 16) * ldc + col0;
#pragma unroll
                for (int bj = 0; bj < 2; ++bj) { const f32x4 v0 = acc[ai][bj][m][0], v1 = acc[ai][bj][m][1];
                    u32x4 w; w.x = cvt_pk_bf16(v0[0], v0[1]); w.y = cvt_pk_bf16(v0[2], v0[3]); w.z = cvt_pk_bf16(v1[0], v1[1]); w.w = cvt_pk_bf16(v1[2], v1[3]);
                    *(u32x4*)(rowp + bj * HALF) = w; } }
    }
};
struct EpiResF32 {
    static constexpr bool PERM = false, AFTER_DRAIN = false;
    const float* res0; const float* res1; int rows0; float* out; int ldc;
    __device__ __forceinline__ void operator()(const f32x4 (&acc)[2][2][4][2], const Unit& u, int wr, int wc, int fr, int fq) const {
        const int col0 = u.pn * BM + wc * 32 + 4 * fq;
#pragma unroll
        for (int ai = 0; ai < 2; ++ai)
#pragma unroll
            for (int m = 0; m < 4; ++m) { const int row = u.pm * BM + ai * HALF + wr * 64 + m * 16 + fr;
                const float* rp = (row < rows0 ? res0 + (size_t)row * ldc : res1 + (size_t)(row - rows0) * ldc) + col0;
                float* op = out + (size_t)row * ldc + col0;
#pragma unroll
                for (int bj = 0; bj < 2; ++bj)
#pragma unroll
                    for (int n = 0; n < 2; ++n) { const f32x4 r = *(const f32x4*)(rp + bj * HALF + n * 16); *(f32x4*)(op + bj * HALF + n * 16) = acc[ai][bj][m][n] + r; } }
    }
};
template <class Epi, class Sched, bool ALIGN_EPI = false, bool SP2 = false>
__device__ __forceinline__ void gemm_phase(PG8_LAS unsigned char* lds, const Gemm g, const Sched& S, const Epi& E) {
    const int tid = threadIdx.x, wid = __builtin_amdgcn_readfirstlane(tid >> 6), lane = tid & 63, wr = wid >> 2, wc = wid & 3, fr = lane & 15, fq = lane >> 4;
    const int K = g.K, nt = K / BK;
    unsigned voffA[2], voffB[2];
#pragma unroll
    for (int i = 0; i < 2; ++i) { int R, C; stage_rc(tid * 16 + i * 8192, R, C); const int Rb = Epi::PERM ? ((R & ~31) + perm32(R & 31)) : R;
        voffA[i] = (unsigned)(R * K + C) * 2u; voffB[i] = (unsigned)(Rb * K + C) * 2u; }
    const size_t kstep = (size_t)(BK * 2);
    const size_t hstep = (size_t)HALF * K * 2;
    const size_t tstep = 2 * hstep;
    const unsigned ldsw = (unsigned)wid * 1024u;
    const int aoff = lds_byte(wr * 64 + fr, fq * 8), boff = lds_byte(wc * 32 + fr, fq * 8);
#define PG8_SA(b, h) (((b) * 2 + (h)) * HTB)
#define PG8_SB(b, h) ((4 + (b) * 2 + (h)) * HTB)
#define PG8_STAGE(bufoff, gbase, voff) do { _Pragma("unroll") for (int _i = 0; _i < 2; ++_i) \
        __builtin_amdgcn_global_load_lds((const unsigned*)((const char*)(gbase) + (voff)[_i]), (PG8_LAS unsigned*)(lds + (bufoff) + ldsw + _i * 8192), 16, 0, 0); } while (0)
#define PG8_LDA(dst, b, h) do { _Pragma("unroll") for (int m = 0; m < 4; ++m) _Pragma("unroll") for (int k = 0; k < 2; ++k) dst[m][k] = *(const PG8_LAS bf16x8*)(lds + PG8_SA(b, h) + aoff + m * 2048 + k * 1024); } while (0)
#define PG8_LDB(dst, b, h) do { _Pragma("unroll") for (int n = 0; n < 2; ++n) _Pragma("unroll") for (int k = 0; k < 2; ++k) dst[n][k] = *(const PG8_LAS bf16x8*)(lds + PG8_SB(b, h) + boff + n * 2048 + k * 1024); } while (0)
#define PG8_MMA(ai, bj, At, Bt) do { __builtin_amdgcn_s_setprio(1); _Pragma("unroll") for (int m = 0; m < 4; ++m) _Pragma("unroll") for (int n = 0; n < 2; ++n) _Pragma("unroll") for (int k = 0; k < 2; ++k) \
        acc[ai][bj][m][n] = __builtin_amdgcn_mfma_f32_16x16x32_bf16(Bt[n][k], At[m][k], acc[ai][bj][m][n], 0, 0, 0); __builtin_amdgcn_s_setprio(0); } while (0)
#define PG8_WAIT_V(n) asm volatile("s_waitcnt vmcnt(" #n ")" ::: "memory")
#define PG8_WAIT_L(n) asm volatile("s_waitcnt lgkmcnt(" #n ")" ::: "memory")
#define PG8_BAR __builtin_amdgcn_s_barrier()
#define PG8_SCHED __builtin_amdgcn_sched_barrier(0)
    Unit cur, nxt; int ui = 0;
    if (!S.next(0, cur)) return;
    f32x4 acc[2][2][4][2];
#pragma unroll
    for (int a = 0; a < 2; ++a)
#pragma unroll
        for (int b = 0; b < 2; ++b)
#pragma unroll
            for (int m = 0; m < 4; ++m)
#pragma unroll
                for (int n = 0; n < 2; ++n) acc[a][b][m][n] = (f32x4){0.f, 0.f, 0.f, 0.f};
    bf16x8 At[4][2], B0[2][2], B1[2][2];
    const char* cA = (const char*)g.A + (size_t)cur.pm * tstep; const char* cB = (const char*)g.Bt + (size_t)cur.pn * tstep;
    S.a_ready(cur);
    if constexpr (SP2) {
        PG8_STAGE(PG8_SB(0, 0), cB, voffB); PG8_STAGE(PG8_SB(0, 1), cB + hstep, voffB); PG8_STAGE(PG8_SA(0, 0), cA, voffA); PG8_STAGE(PG8_SA(0, 1), cA + hstep, voffA);
        if (wr == 1) PG8_BAR;
        PG8_WAIT_V(2); PG8_BAR;
        PG8_STAGE(PG8_SB(1, 0), cB + kstep, voffB); PG8_STAGE(PG8_SA(1, 0), cA + kstep, voffA); PG8_STAGE(PG8_SB(1, 1), cB + hstep + kstep, voffB);
        PG8_WAIT_V(6); PG8_BAR;
    } else {
        PG8_STAGE(PG8_SB(0, 0), cB, voffB); PG8_STAGE(PG8_SA(0, 0), cA, voffA); PG8_STAGE(PG8_SB(0, 1), cB + hstep, voffB); PG8_STAGE(PG8_SA(0, 1), cA + hstep, voffA);
        if (wr == 1) PG8_BAR;
        PG8_WAIT_V(4); PG8_BAR;
        PG8_STAGE(PG8_SB(1, 0), cB + kstep, voffB); PG8_STAGE(PG8_SA(1, 0), cA + kstep, voffA); PG8_STAGE(PG8_SB(1, 1), cB + hstep + kstep, voffB);
        PG8_WAIT_V(6); PG8_BAR;
    }
    for (;;) {
        const bool has_next = S.next(ui + 1, nxt);
        const char* nA = has_next ? (const char*)g.A + (size_t)nxt.pm * tstep : cA; const char* nB = has_next ? (const char*)g.Bt + (size_t)nxt.pn * tstep : cB;
        for (int t = 0; t < nt; t += 2) {
            const bool last = (t == nt - 2);
            const char* a1 = cA + (size_t)(t + 1) * kstep;
            const char* a2 = last ? nA : cA + (size_t)(t + 2) * kstep; const char* b2 = last ? nB : cB + (size_t)(t + 2) * kstep;
            const char* a3 = a2 + kstep; const char* b3 = b2 + kstep;
            if (last && has_next) S.a_ready(nxt);
            if constexpr (SP2) {
            PG8_LDB(B0, 0, 0); PG8_LDB(B1, 0, 1); PG8_SCHED; PG8_LDA(At, 0, 0); PG8_STAGE(PG8_SA(1, 1), a1 + hstep, voffA);
            PG8_WAIT_V(8); PG8_WAIT_L(0); PG8_BAR; PG8_MMA(0, 0, At, B0); PG8_MMA(0, 1, At, B1); PG8_BAR; PG8_SCHED;
            PG8_LDA(At, 0, 1); PG8_STAGE(PG8_SB(0, 0), b2, voffB); PG8_STAGE(PG8_SB(0, 1), b2 + hstep, voffB); PG8_STAGE(PG8_SA(0, 0), a2, voffA);
            PG8_WAIT_V(8); PG8_WAIT_L(0); PG8_BAR; PG8_MMA(1, 0, At, B0); PG8_MMA(1, 1, At, B1); PG8_BAR; PG8_SCHED;
            PG8_LDB(B0, 1, 0); PG8_LDB(B1, 1, 1); PG8_SCHED; PG8_LDA(At, 1, 0); PG8_STAGE(PG8_SA(0, 1), a2 + hstep, voffA);
            PG8_WAIT_V(8); PG8_WAIT_L(0); PG8_BAR; PG8_MMA(0, 0, At, B0); PG8_MMA(0, 1, At, B1); PG8_BAR; PG8_SCHED;
            PG8_LDA(At, 1, 1); PG8_STAGE(PG8_SB(1, 0), b3, voffB); PG8_STAGE(PG8_SB(1, 1), b3 + hstep, voffB); PG8_STAGE(PG8_SA(1, 0), a3, voffA);
            PG8_WAIT_V(8); PG8_WAIT_L(0); PG8_BAR; PG8_MMA(1, 0, At, B0); PG8_MMA(1, 1, At, B1); PG8_BAR; PG8_SCHED;
            } else {
            PG8_LDB(B0, 0, 0); PG8_SCHED; PG8_LDA(At, 0, 0); PG8_STAGE(PG8_SA(1, 1), a1 + hstep, voffA);
            PG8_WAIT_L(8); PG8_BAR; PG8_WAIT_L(0); PG8_MMA(0, 0, At, B0); PG8_BAR; PG8_SCHED;
            PG8_LDB(B1, 0, 1); PG8_STAGE(PG8_SB(0, 0), b2, voffB);
            PG8_BAR; PG8_WAIT_L(0); PG8_MMA(0, 1, At, B1); PG8_BAR;
            PG8_LDA(At, 0, 1); PG8_STAGE(PG8_SA(0, 0), a2, voffA);
            PG8_BAR; PG8_WAIT_L(0); PG8_MMA(1, 0, At, B0); PG8_BAR; PG8_SCHED;
            PG8_STAGE(PG8_SB(0, 1), b2 + hstep, voffB);
            PG8_WAIT_V(6); PG8_BAR; PG8_MMA(1, 1, At, B1); PG8_BAR;
            PG8_LDB(B0, 1, 0); PG8_SCHED; PG8_LDA(At, 1, 0); PG8_STAGE(PG8_SA(0, 1), a2 + hstep, voffA);
            PG8_WAIT_L(8); PG8_BAR; PG8_WAIT_L(0); PG8_MMA(0, 0, At, B0); PG8_BAR; PG8_SCHED;
            PG8_LDB(B1, 1, 1); PG8_STAGE(PG8_SB(1, 0), b3, voffB);
            PG8_BAR; PG8_WAIT_L(0); PG8_MMA(0, 1, At, B1); PG8_BAR;
            PG8_LDA(At, 1, 1); PG8_STAGE(PG8_SA(1, 0), a3, voffA);
            PG8_BAR; PG8_WAIT_L(0); PG8_MMA(1, 0, At, B0); PG8_BAR; PG8_SCHED;
            PG8_STAGE(PG8_SB(1, 1), b3 + hstep, voffB);
            PG8_WAIT_V(6); PG8_BAR; PG8_MMA(1, 1, At, B1); PG8_BAR;
            }
        }
        if constexpr (ALIGN_EPI) { if (wr == 0) PG8_BAR; }
        if constexpr (!Epi::AFTER_DRAIN) { E(acc, cur, wr, wc, fr, fq); S.done(cur); }
        if (!has_next) break;
#pragma unroll
        for (int a = 0; a < 2; ++a)
#pragma unroll
            for (int b = 0; b < 2; ++b)
#pragma unroll
                for (int m = 0; m < 4; ++m)
#pragma unroll
                    for (int n = 0; n < 2; ++n) acc[a][b][m][n] = (f32x4){0.f, 0.f, 0.f, 0.f};
        cur = nxt; cA = nA; cB = nB; ++ui;
        if constexpr (ALIGN_EPI) { if (wr == 1) PG8_BAR; }
    }
    PG8_WAIT_V(0);
    if constexpr (!ALIGN_EPI) { if (wr == 0) PG8_BAR; }
    PG8_BAR;
    if constexpr (Epi::AFTER_DRAIN) { E.fused(acc, cur, wr, wc, fr, fq, lds, wid, lane); S.done(cur); }
#undef PG8_SA
#undef PG8_SB
#undef PG8_STAGE
#undef PG8_LDA
#undef PG8_LDB
#undef PG8_MMA
#undef PG8_WAIT_V
#undef PG8_WAIT_L
#undef PG8_BAR
#undef PG8_SCHED
}
}
#define GAS __attribute__((address_space(1)))
#define LAS __attribute__((address_space(3)))
typedef unsigned short bf16;
typedef unsigned v4u __attribute__((ext_vector_type(4)));
typedef float f32x4 __attribute__((ext_vector_type(4)));
typedef short bf16x8 __attribute__((ext_vector_type(8)));
typedef GAS unsigned gu32;
typedef GAS unsigned long long gu64;
#define RLX_AGENT __ATOMIC_RELAXED, __HIP_MEMORY_SCOPE_AGENT
#define LDS_WAIT() asm volatile("s_waitcnt lgkmcnt(0)" ::: "memory")
#define VM_WAIT() asm volatile("s_waitcnt vmcnt(0)" ::: "memory")
__device__ __forceinline__ unsigned long long rt() { return __builtin_amdgcn_s_memrealtime(); }
__device__ __forceinline__ unsigned f2bf(float f) { unsigned u = __builtin_bit_cast(unsigned, f); return (u + 0x7fffu + ((u >> 16) & 1u)) >> 16; }
__device__ __forceinline__ unsigned pk2(float lo, float hi) { return f2bf(lo) | (f2bf(hi) << 16); }

#define XB_TMO      128
#define XB_XCNT(j)  (256  + 64 * (j))
#define XB_XSUB(j)  (1280 + 64 * (j))
#define XB_XGEN(j)  (2304 + 64 * (j))
#define XB_TOP      3328
#define XB_TOPGEN   3392
#define XCD_BAR_WORDS 3456
#define XB_SPIN_CAP (1u << 18)

__device__ __forceinline__ unsigned xb_ld(unsigned* p)              { return __hip_atomic_load(p, __ATOMIC_RELAXED, __HIP_MEMORY_SCOPE_AGENT); }
__device__ __forceinline__ unsigned xb_add(unsigned* p, unsigned v) { return __hip_atomic_fetch_add(p, v, __ATOMIC_RELAXED, __HIP_MEMORY_SCOPE_AGENT); }
__device__ __forceinline__ unsigned xb_xcc_id() { return (unsigned)__builtin_amdgcn_s_getreg((3 << 11) | 20) & 0xFu; }
#define XB_SPIN(cond, bar) do { unsigned _sp = 0; while (cond) { __builtin_amdgcn_s_sleep(1); \
    if ((++_sp & 255u) == 0u) { if (xb_ld(&(bar)[XB_TMO])) break; if (_sp > XB_SPIN_CAP) { atomicAdd(&(bar)[XB_TMO], 1u); break; } } } } while (0)

struct XcdBarrier {
    unsigned* bar; unsigned x;
    volatile LAS unsigned* st;
};

__device__ __forceinline__ XcdBarrier xcd_barrier_post(unsigned* bar, volatile LAS unsigned* st) {
    XcdBarrier b; b.bar = bar; b.x = xb_xcc_id(); b.st = st;
    if (threadIdx.x == 0) (void)xb_add(&bar[XB_XCNT(b.x)], 1u);
    return b;
}
__device__ __forceinline__ void xcd_barrier_complete(unsigned* bar, unsigned x, unsigned& nloc, unsigned& nx) {
    const unsigned G = gridDim.x * gridDim.y * gridDim.z;
    unsigned sum, cnt, mine, sp = 0u;
    for (;;) {
        sum = 0u; cnt = 0u; mine = 0u;
#pragma unroll
        for (unsigned j = 0; j < 16; ++j) { const unsigned c = xb_ld(&bar[XB_XCNT(j)]); sum += c; cnt += (c > 0u) ? 1u : 0u; mine = (j == x) ? c : mine; }
        if (sum == G) break;
        __builtin_amdgcn_s_sleep(1);
        if ((++sp & 255u) == 0u) { if (xb_ld(&bar[XB_TMO])) break; if (sp > XB_SPIN_CAP) { atomicAdd(&bar[XB_TMO], 1u); break; } }
    }
    nloc = mine > 0u ? mine : 1u; nx = cnt > 0u ? cnt : 1u;
}

__device__ __forceinline__ void xcd_barrier(const XcdBarrier& b) {
    asm volatile("s_waitcnt vmcnt(0)" ::: "memory");
    __syncthreads();
    if (threadIdx.x == 0) {
        unsigned* bar = b.bar;
        __builtin_amdgcn_s_waitcnt(0);
        unsigned nloc = b.st[0], nx = b.st[1];
        if (nloc == 0u) { xcd_barrier_complete(bar, b.x, nloc, nx); b.st[0] = nloc; b.st[1] = nx; }
        const unsigned old = xb_add(&bar[XB_XSUB(b.x)], 1u);
        const unsigned gen = old / nloc;
        if (old + 1u == (gen + 1u) * nloc) {
            __builtin_amdgcn_fence(__ATOMIC_RELEASE, "agent");
            asm volatile("s_waitcnt vmcnt(0)" ::: "memory");
            const unsigned og = xb_add(&bar[XB_TOP], 1u);
            const unsigned tg = og / nx;
            if (og + 1u == (tg + 1u) * nx) xb_add(&bar[XB_TOPGEN], 1u);
            else XB_SPIN(xb_ld(&bar[XB_TOPGEN]) == tg, bar);
            __builtin_amdgcn_fence(__ATOMIC_ACQUIRE, "agent");
            xb_add(&bar[XB_XGEN(b.x)], 1u);
            asm volatile("s_waitcnt vmcnt(0)" ::: "memory");
        } else {
            XB_SPIN(xb_ld(&bar[XB_XGEN(b.x)]) == gen, bar);
            __builtin_amdgcn_fence(__ATOMIC_ACQUIRE, "agent");
            asm volatile("s_waitcnt vmcnt(0)" ::: "memory");
        }
    }
    __syncthreads();
}

constexpr int DM = 1024, SEQ = 8192, PB = 4, SB = 128, ST = 4, LBUF = 2048;
constexpr int NP = PB * SEQ;
constexpr int NS = SB * ST;
constexpr int MT = NP + NS;
constexpr int DIN = 4104, NPROJ = 4096;
constexpr int CONVCH = 1536;
constexpr int PC_ZA = 1536, PC_QB = 2048, PC_KB = 2560, PC_VB = 3072, PC_ZB = 3584;
constexpr float NORM_EPS = 1e-6f;
constexpr size_t O_YP = 0, O_YS = (size_t)NP * DM, O_CONVP = O_YS + (size_t)NS * DM, O_DELTAP = O_CONVP + (size_t)PB * 3 * CONVCH,
                 O_KWP = O_DELTAP + (size_t)PB * 4 * 128 * 128, O_VWP = O_KWP + (size_t)PB * LBUF * 512, O_CONVS = O_VWP + (size_t)PB * LBUF * 512,
                 O_DELTAS = O_CONVS + (size_t)SB * 3 * CONVCH, O_KWS = O_DELTAS + (size_t)SB * 4 * 128 * 128, O_VWS = O_KWS + (size_t)SB * LBUF * 512,
                 O_END = O_VWS + (size_t)SB * LBUF * 512;
constexpr size_t MiB = 1u << 20;
constexpr size_t WS_CTL = 0, CTL_ZERO_BYTES = 1 * MiB;
constexpr size_t WS_WIN = 2 * MiB, WS_WOUT = 10 * MiB, WS_GB = 12 * MiB, WS_XN = 16 * MiB, WS_PROJ = 96 * MiB, WS_OA = 360 * MiB, WS_MIX = 432 * MiB, WS_END = 512 * MiB;
constexpr int CW_TMO = 0, CW_BAR = 4096;
constexpr int LDS_BYTES = 147456, RING_BYTES = 131072, LDSCTL_OFF = RING_BYTES, MISC_OFF = LDSCTL_OFF + 320;
constexpr int NWAVES = 8, NTHR = 512;

struct Args { const float* in[14]; float* out; unsigned char* ws; int ph_lo, ph_hi; };
enum { I_XP = 0, I_XS, I_SCONV, I_SDELTA, I_CK, I_CV, I_NORMG, I_FNORMG, I_WIN, I_CONVW, I_ALOG, I_DTB, I_DNG, I_WOUT };

struct Frame {
    LAS unsigned char* lds;
    int tid, lane, wave, G;
    const float* in[14]; float* out; unsigned char* ws;
    bf16 *WinT, *WoutT, *XN, *PROJ, *MIX; float *GB, *OA;
};

__device__ __forceinline__ float wave_sum(float v) {
#pragma unroll
    for (int o = 1; o < 64; o <<= 1) v += __shfl_xor(v, o);
    return v;
}
__device__ __forceinline__ float bf2f(bf16 v) { return __uint_as_float((unsigned)v << 16); }
__device__ __forceinline__ float bflo(unsigned w) { return __uint_as_float(w << 16); }
__device__ __forceinline__ float bfhi(unsigned w) { return __uint_as_float(w & 0xffff0000u); }
__device__ __forceinline__ float siluf(float y) { return y / (1.f + __expf(-y)); }

__device__ __forceinline__ void p0_transpose_item(const float* W, int K, int ldw, int c0, bf16* WT, int n0, int k0, LAS float* scr, int lane) {
#pragma unroll 8
    for (int i = 0; i < 32; ++i) { const int kk = 2 * i + (lane >> 5); scr[kk * 33 + (lane & 31)] = W[(size_t)(k0 + kk) * ldw + c0 + (lane & 31)]; }
    LDS_WAIT(); asm volatile("" ::: "memory");
    const int c = lane & 7;
#pragma unroll
    for (int j = 0; j < 4; ++j) { const int n = (lane >> 3) + 8 * j; const LAS float* s = scr + (8 * c) * 33 + n;
        v4u o; o.x = pk2(s[0 * 33], s[1 * 33]); o.y = pk2(s[2 * 33], s[3 * 33]); o.z = pk2(s[4 * 33], s[5 * 33]); o.w = pk2(s[6 * 33], s[7 * 33]);
        *(GAS v4u*)(WT + (size_t)(n0 + n) * K + k0 + 8 * c) = o; }
    LDS_WAIT(); asm volatile("" ::: "memory");
}
__device__ __forceinline__ void p0_prologue(Frame& F) {
    LAS float* W8T = (LAS float*)(F.lds);
    const float* w_in = F.in[I_WIN];
    for (int i = F.tid; i < 8 * 1024; i += NTHR) { const int k = i >> 3, e = i & 7; W8T[e * 1024 + k] = w_in[(size_t)k * DIN + 2048 + e]; }
    __syncthreads();
    const int gw = blockIdx.x * NWAVES + F.wave, NGW = F.G * NWAVES;
    const float* ng = F.in[I_NORMG];
    f32x4 gv[4];
#pragma unroll
    for (int j = 0; j < 4; ++j) gv[j] = *(const f32x4*)(ng + 4 * F.lane + 256 * j);
    const float a_log_l = (F.lane < 4) ? F.in[I_ALOG][F.lane] : 0.f, dtb_l = (F.lane < 4) ? F.in[I_DTB][F.lane] : 0.f;
    for (int m = gw; m < MT; m += NGW) {
        const float* xrow = (m < NP) ? F.in[I_XP] + (size_t)m * DM : F.in[I_XS] + (size_t)(m - NP) * DM;
        const GAS f32x4* xr = (const GAS f32x4*)xrow + F.lane;
        f32x4 v[4]; float s = 0.f;
#pragma unroll
        for (int j = 0; j < 4; ++j) { v[j] = xr[64 * j]; s += (v[j].x * v[j].x + v[j].y * v[j].y) + (v[j].z * v[j].z + v[j].w * v[j].w); }
        const float rs = 1.f / sqrtf(wave_sum(s) * (1.f / DM) + NORM_EPS);
#pragma unroll
        for (int j = 0; j < 4; ++j) v[j] = v[j] * rs * gv[j];
        GAS unsigned long long* o8 = (GAS unsigned long long*)(F.XN + (size_t)m * DM) + F.lane;
#pragma unroll
        for (int j = 0; j < 4; ++j) o8[64 * j] = (unsigned long long)pk2(v[j].x, v[j].y) | ((unsigned long long)pk2(v[j].z, v[j].w) << 32);
        float d[8];
#pragma unroll
        for (int e = 0; e < 8; ++e) { float acc = 0.f;
#pragma unroll
            for (int j = 0; j < 4; ++j) { const f32x4 w = *(const LAS f32x4*)(W8T + e * 1024 + 4 * F.lane + 256 * j); acc += (v[j].x * w.x + v[j].y * w.y) + (v[j].z * w.z + v[j].w * w.w); }
            d[e] = wave_sum(acc); }
        float mine = 0.f;
#pragma unroll
        for (int e = 0; e < 8; ++e) mine = (F.lane == e) ? d[e] : mine;
        if (F.lane < 4) { const float xx = mine + dtb_l; const float sp = xx > 20.f ? xx : log1pf(expf(xx)); F.GB[(size_t)m * 8 + F.lane] = -expf(a_log_l) * sp; }
        else if (F.lane < 8) { F.GB[(size_t)m * 8 + F.lane] = 1.f / (1.f + expf(-mine)); }
    }
    __syncthreads();
    LAS float* scr = (LAS float*)(F.lds + 32768 + F.wave * 8448);
    constexpr int I_IN = (DM / 64) * (NPROJ / 32), I_OUT = (DM / 64) * (DM / 32);
    for (int it = gw; it < I_IN + I_OUT; it += NGW) {
        if (it < I_IN) { const int kb = it / (NPROJ / 32), nb = it % (NPROJ / 32), n0 = nb * 32; p0_transpose_item(w_in, DM, DIN, n0 + (n0 >= 2048 ? 8 : 0), F.WinT, n0, kb * 64, scr, F.lane); }
        else { const int r = it - I_IN, kb = r / (DM / 32), nb = r % (DM / 32); p0_transpose_item(F.in[I_WOUT], DM, DM, nb * 32, F.WoutT, nb * 32, kb * 64, scr, F.lane); }
    }
}

__device__ __forceinline__ void dn_seq_unit(Frame& F, int unit) {
    LAS float* cv = (LAS float*)F.lds;
    LAS float* part = cv + 384;
    LAS float* psum = cv + 512;
    LAS float* osum = cv + 1024;
    const int t = F.tid, dv = t & 127, qd = t >> 7;
    int L, row0, h; const float* prefix; const float* S0; float* Sout;
    if (unit < 16) { const int b = unit >> 2; h = unit & 3; L = SEQ; row0 = b * SEQ; prefix = nullptr; S0 = nullptr; Sout = F.out + O_DELTAP + (size_t)unit * 16384; }
    else { const int u = unit - 16, b = u >> 2; h = u & 3; L = ST; row0 = NP + b * ST; prefix = F.in[I_SCONV] + (size_t)b * 3 * CONVCH; S0 = F.in[I_SDELTA] + (size_t)u * 16384; Sout = F.out + O_DELTAS + (size_t)u * 16384; }
    float S[32];
#pragma unroll
    for (int i = 0; i < 32; ++i) S[i] = S0 ? S0[(size_t)(qd * 32 + i) * 128 + dv] : 0.f;
    const int which = t >> 7, ch = t & 127, gcol = (which < 3 ? which : 0) * 512 + h * 128 + ch;
    float w0 = 0.f, w1 = 0.f, w2 = 0.f, w3 = 0.f, x0 = 0.f, x1 = 0.f, x2 = 0.f;
    if (t < 384) { const float* cw = F.in[I_CONVW]; w0 = cw[gcol]; w1 = cw[CONVCH + gcol]; w2 = cw[2 * CONVCH + gcol]; w3 = cw[3 * CONVCH + gcol];
        if (prefix) { x0 = prefix[gcol]; x1 = prefix[CONVCH + gcol]; x2 = prefix[2 * CONVCH + gcol]; } }
    __syncthreads();
    for (int tau = 0; tau < L; ++tau) {
        const size_t row = (size_t)(row0 + tau);
        float ss = 0.f;
        if (t < 384) { const float x3 = bf2f(F.PROJ[row * NPROJ + gcol]); float y = w0 * x0 + w1 * x1 + w2 * x2 + w3 * x3; x0 = x1; x1 = x2; x2 = x3; y = siluf(y); cv[t] = y; ss = (t < 256) ? y * y : 0.f; }
        if (F.wave < 4) { ss = wave_sum(ss); if (F.lane == 0) part[F.wave] = ss; }
        __syncthreads();
        const float qn = (1.f / sqrtf(part[0] + part[1] + NORM_EPS)) * 0.08838834764831845f, kn = 1.f / sqrtf(part[2] + part[3] + NORM_EPS);
        const float g = F.GB[row * 8 + h], beta = F.GB[row * 8 + 4 + h], a = expf(g);
        float p = 0.f;
#pragma unroll
        for (int i = 0; i < 32; ++i) { S[i] *= a; p += S[i] * cv[128 + qd * 32 + i]; }
        psum[qd * 128 + dv] = p * kn;
        __syncthreads();
        const float ptot = (psum[dv] + psum[128 + dv]) + (psum[256 + dv] + psum[384 + dv]);
        const float r = beta * (cv[256 + dv] - ptot);
        float o = 0.f;
#pragma unroll
        for (int i = 0; i < 32; ++i) { S[i] += (cv[128 + qd * 32 + i] * kn) * r; o += S[i] * cv[qd * 32 + i]; }
        osum[qd * 128 + dv] = o * qn;
        __syncthreads();
        if (qd == 0) F.OA[row * 512 + h * 128 + dv] = (osum[dv] + osum[128 + dv]) + (osum[256 + dv] + osum[384 + dv]);
    }
#pragma unroll
    for (int i = 0; i < 32; ++i) Sout[(size_t)(qd * 32 + i) * 128 + dv] = S[i];
    __syncthreads();
}

__device__ __forceinline__ void ld_bf16x64(const bf16* p, float (&v)[64]) {
    const v4u* p4 = (const v4u*)p;
#pragma unroll
    for (int i = 0; i < 8; ++i) { const v4u w = p4[i]; v[8 * i] = bflo(w.x); v[8 * i + 1] = bfhi(w.x); v[8 * i + 2] = bflo(w.y); v[8 * i + 3] = bfhi(w.y); v[8 * i + 4] = bflo(w.z); v[8 * i + 5] = bfhi(w.z); v[8 * i + 6] = bflo(w.w); v[8 * i + 7] = bfhi(w.w); }
}
__device__ __forceinline__ float dot_bf16row(const bf16* p, const float (&q)[64]) {
    const v4u* p4 = (const v4u*)p; float s = 0.f;
#pragma unroll
    for (int i = 0; i < 8; ++i) { const v4u w = p4[i]; s += q[8 * i] * bflo(w.x) + q[8 * i + 1] * bfhi(w.x) + q[8 * i + 2] * bflo(w.y) + q[8 * i + 3] * bfhi(w.y) + q[8 * i + 4] * bflo(w.z) + q[8 * i + 5] * bfhi(w.z) + q[8 * i + 6] * bflo(w.w) + q[8 * i + 7] * bfhi(w.w); }
    return s;
}
__device__ __forceinline__ void axpy_bf16row(const bf16* p, float a, float sc, float (&o)[64]) {
    const v4u* p4 = (const v4u*)p;
#pragma unroll
    for (int i = 0; i < 8; ++i) { const v4u w = p4[i];
        o[8 * i] = o[8 * i] * sc + a * bflo(w.x); o[8 * i + 1] = o[8 * i + 1] * sc + a * bfhi(w.x); o[8 * i + 2] = o[8 * i + 2] * sc + a * bflo(w.y); o[8 * i + 3] = o[8 * i + 3] * sc + a * bfhi(w.y);
        o[8 * i + 4] = o[8 * i + 4] * sc + a * bflo(w.z); o[8 * i + 5] = o[8 * i + 5] * sc + a * bfhi(w.z); o[8 * i + 6] = o[8 * i + 6] * sc + a * bflo(w.w); o[8 * i + 7] = o[8 * i + 7] * sc + a * bfhi(w.w); }
}
__device__ __forceinline__ float dot_f32row(const float* p, const float (&q)[64]) {
    const f32x4* p4 = (const f32x4*)p; float s = 0.f;
#pragma unroll
    for (int i = 0; i < 16; ++i) { const f32x4 w = p4[i]; s += q[4 * i] * w.x + q[4 * i + 1] * w.y + q[4 * i + 2] * w.z + q[4 * i + 3] * w.w; }
    return s;
}
__device__ __forceinline__ void axpy_f32row(const float* p, float a, float sc, float (&o)[64]) {
    const f32x4* p4 = (const f32x4*)p;
#pragma unroll
    for (int i = 0; i < 16; ++i) { const f32x4 w = p4[i]; o[4 * i] = o[4 * i] * sc + a * w.x; o[4 * i + 1] = o[4 * i + 1] * sc + a * w.y; o[4 * i + 2] = o[4 * i + 2] * sc + a * w.z; o[4 * i + 3] = o[4 * i + 3] * sc + a * w.w; }
}
__device__ __forceinline__ void attn_write(Frame& F, size_t row, int h, const float (&o)[64], float l) {
    float z[64]; ld_bf16x64(F.PROJ + row * NPROJ + PC_ZB + h * 64, z);
    const float il = 1.f / l;
    v4u* dst = (v4u*)(F.MIX + row * DM + 512 + h * 64);
#pragma unroll
    for (int i = 0; i < 8; ++i) { v4u w; w.x = pk2(o[8 * i] * il * siluf(z[8 * i]), o[8 * i + 1] * il * siluf(z[8 * i + 1])); w.y = pk2(o[8 * i + 2] * il * siluf(z[8 * i + 2]), o[8 * i + 3] * il * siluf(z[8 * i + 3]));
        w.z = pk2(o[8 * i + 4] * il * siluf(z[8 * i + 4]), o[8 * i + 5] * il * siluf(z[8 * i + 5])); w.w = pk2(o[8 * i + 6] * il * siluf(z[8 * i + 6]), o[8 * i + 7] * il * siluf(z[8 * i + 7])); dst[i] = w; }
}
__device__ __forceinline__ void attn_simple(Frame& F) {
    const int gt = blockIdx.x * NTHR + F.tid, NGT = F.G * NTHR;
    for (int it = gt; it < PB * 8 * SEQ; it += NGT) {
        const int bh = it >> 13, pos = it & (SEQ - 1), b = bh >> 3, h = bh & 7; const size_t row = (size_t)b * SEQ + pos;
        float q[64]; ld_bf16x64(F.PROJ + row * NPROJ + PC_QB + h * 64, q);
#pragma unroll
        for (int i = 0; i < 64; ++i) q[i] *= 0.125f;
        float o[64];
#pragma unroll
        for (int i = 0; i < 64; ++i) o[i] = 0.f;
        float m = -INFINITY, l = 0.f;
        for (int br = 0; br < 3; ++br) { const int d = br == 0 ? 1 : (br == 1 ? 4 : 16);
            for (int j = 0; j <= 128; ++j) { const int kp = pos - d * j; if (kp < 0) break;
                const bf16* kr = F.PROJ + ((size_t)b * SEQ + kp) * NPROJ + h * 64;
                const float s = dot_bf16row(kr + PC_KB, q); const float mn = fmaxf(m, s), sc = __expf(m - mn), p = __expf(s - mn);
                l = l * sc + p; axpy_bf16row(kr + PC_VB, p, sc, o); m = mn; } }
        attn_write(F, row, h, o, l);
    }
    for (int it = gt; it < SB * 8 * ST; it += NGT) {
        const int t = it & 3, bh = it >> 2, b = bh >> 3, h = bh & 7; const size_t row = (size_t)NP + b * ST + t;
        float q[64]; ld_bf16x64(F.PROJ + row * NPROJ + PC_QB + h * 64, q);
#pragma unroll
        for (int i = 0; i < 64; ++i) q[i] *= 0.125f;
        float o[64];
#pragma unroll
        for (int i = 0; i < 64; ++i) o[i] = 0.f;
        float m = -INFINITY, l = 0.f;
        for (int br = 0; br < 3; ++br) { const int d = br == 0 ? 1 : (br == 1 ? 4 : 16);
            for (int j = 0; j <= 128; ++j) { const int idx = LBUF + t - d * j; if (idx < 0) break;
                float s;
                if (idx >= LBUF) { const bf16* kr = F.PROJ + ((size_t)NP + b * ST + (idx - LBUF)) * NPROJ + h * 64; s = dot_bf16row(kr + PC_KB, q);
                    const float mn = fmaxf(m, s), sc = __expf(m - mn), p = __expf(s - mn); l = l * sc + p; axpy_bf16row(kr + PC_VB, p, sc, o); m = mn; }
                else { const size_t off = ((size_t)b * LBUF + idx) * 512 + h * 64; s = dot_f32row(F.in[I_CK] + off, q);
                    const float mn = fmaxf(m, s), sc = __expf(m - mn), p = __expf(s - mn); l = l * sc + p; axpy_f32row(F.in[I_CV] + off, p, sc, o); m = mn; } } }
        attn_write(F, row, h, o, l);
    }
}

__device__ __forceinline__ f32x4 ld4bf(const bf16* p) { const unsigned long long w = *(const unsigned long long*)p; return (f32x4){bflo((unsigned)w), bfhi((unsigned)w), bflo((unsigned)(w >> 32)), bfhi((unsigned)(w >> 32))}; }
__device__ __forceinline__ void copy_outputs(Frame& F) {
    const size_t gt = (size_t)blockIdx.x * NTHR + F.tid, NGT = (size_t)F.G * NTHR;
    for (size_t i = gt; i < ((size_t)2 << 25); i += NGT) {
        const int which = (int)(i >> 25); const size_t rem = i & (((size_t)1 << 25) - 1); const int b = (int)(rem >> 18), w = (int)(rem & ((1 << 18) - 1)), r = w >> 7, c4 = w & 127;
        f32x4 v;
        if (r < LBUF - ST) v = *(const f32x4*)(F.in[which ? I_CV : I_CK] + ((size_t)b * LBUF + r + ST) * 512 + c4 * 4);
        else v = ld4bf(F.PROJ + ((size_t)NP + b * ST + (r - (LBUF - ST))) * NPROJ + (which ? PC_VB : PC_KB) + c4 * 4);
        *(f32x4*)(F.out + (which ? O_VWS : O_KWS) + rem * 4) = v;
    }
    for (size_t i = gt; i < ((size_t)2 << 20); i += NGT) {
        const int which = (int)(i >> 20); const size_t rem = i & (((size_t)1 << 20) - 1); const int b = (int)(rem >> 18), w = (int)(rem & ((1 << 18) - 1)), r = w >> 7, c4 = w & 127;
        *(f32x4*)(F.out + (which ? O_VWP : O_KWP) + rem * 4) = ld4bf(F.PROJ + ((size_t)b * SEQ + (SEQ - LBUF) + r) * NPROJ + (which ? PC_VB : PC_KB) + c4 * 4);
    }
    for (size_t i = gt; i < (size_t)(PB + SB) * 3 * (CONVCH / 4); i += NGT) {
        const int c4 = (int)(i % (CONVCH / 4)), rr = (int)(i / (CONVCH / 4)), j = rr % 3, b = rr / 3;
        if (b < PB) *(f32x4*)(F.out + O_CONVP + ((size_t)b * 3 + j) * CONVCH + c4 * 4) = ld4bf(F.PROJ + ((size_t)b * SEQ + SEQ - 3 + j) * NPROJ + c4 * 4);
        else { const int bs = b - PB; *(f32x4*)(F.out + O_CONVS + ((size_t)bs * 3 + j) * CONVCH + c4 * 4) = ld4bf(F.PROJ + ((size_t)NP + bs * ST + 1 + j) * NPROJ + c4 * 4); }
    }
}

__device__ __forceinline__ void mix_a_finish(Frame& F) {
    const int gw = blockIdx.x * NWAVES + F.wave, NGW = F.G * NWAVES;
    const float g0 = F.in[I_DNG][2 * F.lane], g1 = F.in[I_DNG][2 * F.lane + 1];
    for (int it = gw; it < MT * 4; it += NGW) {
        const size_t row = (size_t)(it >> 2); const int h = it & 3;
        const float2 v = *(const float2*)(F.OA + row * 512 + h * 128 + 2 * F.lane);
        const float rs = 1.f / sqrtf(wave_sum(v.x * v.x + v.y * v.y) * (1.f / 128.f) + NORM_EPS);
        const unsigned zw = *(const unsigned*)(F.PROJ + row * NPROJ + PC_ZA + h * 128 + 2 * F.lane);
        *(unsigned*)(F.MIX + row * DM + h * 128 + 2 * F.lane) = pk2(v.x * rs * g0 * siluf(bflo(zw)), v.y * rs * g1 * siluf(bfhi(zw)));
    }
}
__device__ __forceinline__ void final_norm(Frame& F) {
    const int gw = blockIdx.x * NWAVES + F.wave, NGW = F.G * NWAVES;
    f32x4 gv[4];
#pragma unroll
    for (int j = 0; j < 4; ++j) gv[j] = *(const f32x4*)(F.in[I_FNORMG] + 4 * F.lane + 256 * j);
    for (int m = gw; m < MT; m += NGW) {
        GAS f32x4* yr = (GAS f32x4*)(F.out + (size_t)m * DM) + F.lane;
        f32x4 v[4]; float s = 0.f;
#pragma unroll
        for (int j = 0; j < 4; ++j) { v[j] = yr[64 * j]; s += (v[j].x * v[j].x + v[j].y * v[j].y) + (v[j].z * v[j].z + v[j].w * v[j].w); }
        const float rs = 1.f / sqrtf(wave_sum(s) * (1.f / DM) + NORM_EPS);
#pragma unroll
        for (int j = 0; j < 4; ++j) yr[64 * j] = v[j] * rs * gv[j];
    }
}

#ifndef MK_N_LAUNCHES
#define MK_N_LAUNCHES 7
#endif
constexpr int N_PHASES = 7, N_LAUNCHES = MK_N_LAUNCHES;
__global__ void __launch_bounds__(NTHR, 2) hymba_fwd(Args args) {
    extern __shared__ __attribute__((aligned(16))) unsigned char lds[];
    Frame F;
    F.lds = (LAS unsigned char*)lds;
    F.tid = threadIdx.x; F.lane = F.tid & 63; F.wave = __builtin_amdgcn_readfirstlane(F.tid >> 6); F.G = gridDim.x;
#pragma unroll
    for (int i = 0; i < 14; ++i) F.in[i] = args.in[i];
    F.out = args.out; F.ws = args.ws;
    F.WinT = (bf16*)(args.ws + WS_WIN); F.WoutT = (bf16*)(args.ws + WS_WOUT); F.XN = (bf16*)(args.ws + WS_XN); F.PROJ = (bf16*)(args.ws + WS_PROJ); F.MIX = (bf16*)(args.ws + WS_MIX);
    F.GB = (float*)(args.ws + WS_GB); F.OA = (float*)(args.ws + WS_OA);
    volatile LAS unsigned* MISC = (volatile LAS unsigned*)(F.lds + MISC_OFF);
    for (int u = F.tid; u < (LDS_BYTES - LDSCTL_OFF) / 4; u += NTHR) ((LAS unsigned*)(F.lds + LDSCTL_OFF))[u] = 0u;
    __syncthreads();
    unsigned* barw = (unsigned*)(args.ws + WS_CTL) + CW_BAR;
    XcdBarrier bar; bar.bar = barw; bar.x = 0; bar.st = nullptr;
    if (N_LAUNCHES == 1) bar = xcd_barrier_post(barw, MISC + 8);
    const int lo = args.ph_lo, hi = args.ph_hi;
#define IN(k) (lo <= (k) && (k) < hi)
#define BOTH(k) (IN(k) && IN((k) + 1))
#define GRID_BAR() do { if (N_LAUNCHES == 1) xcd_barrier(bar); } while (0)

    if (IN(0)) { p0_prologue(F); if (BOTH(0)) GRID_BAR(); }
    if (IN(1)) {
        pg8::Gemm g{F.XN, F.WinT, MT, NPROJ, DM}; pg8::StaticOrder S; S.init(MT, NPROJ, F.G, (int)blockIdx.x);
        pg8::EpiBf16 E{F.PROJ, NPROJ};
        pg8::gemm_phase<pg8::EpiBf16, pg8::StaticOrder, true, true>(F.lds, g, S, E);
        if (BOTH(1)) GRID_BAR();
    }
    if (IN(2)) {
        for (int u = blockIdx.x; u < 16 + SB * 4; u += F.G) dn_seq_unit(F, u);
        if (BOTH(2)) GRID_BAR();
    }
    if (IN(3)) { attn_simple(F); copy_outputs(F); if (BOTH(3)) GRID_BAR(); }
    if (IN(4)) { mix_a_finish(F); if (BOTH(4)) GRID_BAR(); }
    if (IN(5)) {
        pg8::Gemm g{F.MIX, F.WoutT, MT, DM, DM}; pg8::StaticOrder S; S.init(MT, DM, F.G, (int)blockIdx.x);
        pg8::EpiResF32 E{F.in[I_XP], F.in[I_XS], NP, F.out, DM};
        pg8::gemm_phase<pg8::EpiResF32, pg8::StaticOrder, true, true>(F.lds, g, S, E);
        if (BOTH(5)) GRID_BAR();
    }
    if (IN(6)) { final_norm(F); }
#undef IN
#undef BOTH
}

extern "C" void kernel_launch(void* const* d_in, const int* in_sizes, int n_in, void* d_out, int out_size, void* d_ws, size_t ws_size, hipStream_t stream) {
    static int grid = 0;
    if (grid == 0) {
        if (n_in != 14 || (size_t)out_size != O_END || ws_size < WS_END) { fprintf(stderr, "kernel_launch: unexpected shapes (n_in %d, out %d, ws %zu); nothing launched\n", n_in, out_size, ws_size); grid = -1; return; }
        int dev = 0, cus = 0, per_cu = 0;
        if (hipGetDevice(&dev) != hipSuccess || hipDeviceGetAttribute(&cus, hipDeviceAttributeMultiprocessorCount, dev) != hipSuccess) { grid = -1; return; }
        if (hipFuncSetAttribute((const void*)hymba_fwd, hipFuncAttributeMaxDynamicSharedMemorySize, LDS_BYTES) != hipSuccess) { fprintf(stderr, "kernel_launch: hipFuncSetAttribute failed\n"); grid = -1; return; }
        if (hipOccupancyMaxActiveBlocksPerMultiprocessor(&per_cu, (const void*)hymba_fwd, NTHR, LDS_BYTES) != hipSuccess || per_cu < 1) fprintf(stderr, "kernel_launch: occupancy query says %d\n", per_cu);
        (void)hipGetLastError();
        grid = cus;
    }
    if (grid < 0) return;
    if (hipMemsetAsync((char*)d_ws + WS_CTL, 0, CTL_ZERO_BYTES, stream) != hipSuccess) return;
    Args a{};
    for (int i = 0; i < 14; ++i) a.in[i] = (const float*)d_in[i];
    a.out = (float*)d_out; a.ws = (unsigned char*)d_ws;
    if (N_LAUNCHES == 1) { a.ph_lo = 0; a.ph_hi = N_PHASES; hipLaunchKernelGGL(hymba_fwd, dim3(grid), dim3(NTHR), LDS_BYTES, stream, a); }
    else for (int li = 0; li < N_PHASES; ++li) { a.ph_lo = li; a.ph_hi = li + 1; hipLaunchKernelGGL(hymba_fwd, dim3(grid), dim3(NTHR), LDS_BYTES, stream, a); }
}
```

```cpp
#include <hip/hip_runtime.h>
#include <cstdio>
#include <cstdint>
namespace pg8 {
#define PG8_LAS __attribute__((address_space(3)))
typedef unsigned short bf16_t;
typedef short bf16x8 __attribute__((ext_vector_type(8)));
typedef float f32x4 __attribute__((ext_vector_type(4)));
typedef unsigned u32x4 __attribute__((ext_vector_type(4)));
constexpr int BM = 256, BK = 64, HALF = 128, HTB = HALF * BK * 2  , STAGE_BYTES = 8 * HTB, NXCD = 8, WGM = 8;

__host__ __device__ __forceinline__ int lds_byte(int r, int c) { const int st = (r >> 4) * 2 + (c >> 5), rr = r & 15, cc = c & 31, ob = rr * 64 + cc * 2; return st * 1024 + (ob ^ (((ob >> 9) & 1) << 5)); }
__host__ __device__ __forceinline__ void stage_rc(int b, int& R, int& C) { const int st = b / 1024, sb = b % 1024, swz = sb ^ (((sb >> 9) & 1) << 5); R = (st >> 1) * 16 + swz / 64; C = (st & 1) * 32 + (swz % 64) / 2; }
__host__ __device__ __forceinline__ int perm32(int rho) { const int n = rho >> 4, i = rho & 15; return 8 * (i >> 2) + 4 * n + (i & 3); }

struct Unit { int pm, pn; };
struct Gemm { const bf16_t* A; const bf16_t* Bt; int M, N, K; };

struct StaticOrder {
    int nM, nN, nwg, G, c;
    __host__ __device__ void init(int M, int N, int G_, int c_) { nM = M / BM; nN = N / BM; nwg = nM * nN; G = G_; c = c_; }
    __host__ __device__ bool next(int i, Unit& u) const {
        const long L = (long)i * G + c; if (L >= nwg) return false;
        int wgid = (int)L; { const int q = nwg / NXCD, r = nwg % NXCD, xcd = wgid % NXCD, off = wgid / NXCD; wgid = (xcd < r ? xcd * (q + 1) : r * (q + 1) + (xcd - r) * q) + off; }
        const int nig = WGM * nN, gid = wgid / nig, fm = gid * WGM, gsz = (nM - fm) < WGM ? (nM - fm) : WGM;
        u.pm = fm + ((wgid % nig) % gsz); u.pn = (wgid % nig) / gsz; return true;
    }
    __device__ __forceinline__ void a_ready(const Unit&) const {}
    __device__ __forceinline__ void done(const Unit&) const {}
};

__device__ __forceinline__ unsigned cvt_pk_bf16(float lo, float hi) { unsigned r; asm volatile("v_cvt_pk_bf16_f32 %0, %1, %2" : "=v"(r) : "v"(lo), "v"(hi)); return r; }
typedef float f32x2 __attribute__((ext_vector_type(2)));
struct EpiBf16 {
    static constexpr bool PERM = true, AFTER_DRAIN = false;
    bf16_t* O; int ldc;
    __device__ __forceinline__ void operator()(const f32x4 (&acc)[2][2][4][2], const Unit& u, int wr, int wc, int fr, int fq) const {
        const int row0 = u.pm * BM + wr * 64 + fr; const int col0 = u.pn * BM + wc * 32 + 8 * fq;
#pragma unroll
        for (int ai = 0; ai < 2; ++ai)
#pragma unroll
            for (int m = 0; m < 4; ++m) { bf16_t* rowp = O + (size_t)(row0 + ai * HALF + m * 16) * ldc + col0;
#pragma unroll
                for (int bj = 0; bj < 2; ++bj) { const f32x4 v0 = acc[ai][bj][m][0], v1 = acc[ai][bj][m][1];
                    u32x4 w; w.x = cvt_pk_bf16(v0[0], v0[1]); w.y = cvt_pk_bf16(v0[2], v0[3]); w.z = cvt_pk_bf16(v1[0], v1[1]); w.w = cvt_pk_bf16(v1[2], v1[3]);
                    *(u32x4*)(rowp + bj * HALF) = w; } }
    }
};
struct EpiResF32 {
    static constexpr bool PERM = false, AFTER_DRAIN = false;
    const float* res0; const float* res1; int rows0; float* out; int ldc;
    __device__ __forceinline__ void operator()(const f32x4 (&acc)[2][2][4][2], const Unit& u, int wr, int wc, int fr, int fq) const {
        const int col0 = u.pn * BM + wc * 32 + 4 * fq;
#pragma unroll
        for (int ai = 0; ai < 2; ++ai)
#pragma unroll
            for (int m = 0; m < 4; ++m) { const int row = u.pm * BM + ai * HALF + wr * 64 + m * 16 + fr;
                const float* rp = (row < rows0 ? res0 + (size_t)row * ldc : res1 + (size_t)(row - rows0) * ldc) + col0;
                float* op = out + (size_t)row * ldc + col0;
#pragma unroll
                for (int bj = 0; bj < 2; ++bj)
#pragma unroll
                    for (int n = 0; n < 2; ++n) { const f32x4 r = *(const f32x4*)(rp + bj * HALF + n * 16); *(f32x4*)(op + bj * HALF + n * 16) = acc[ai][bj][m][n] + r; } }
    }
};
template <class Epi, class Sched, bool ALIGN_EPI = false, bool SP2 = false>
__device__ __forceinline__ void gemm_phase(PG8_LAS unsigned char* lds, const Gemm g, const Sched& S, const Epi& E) {
    const int tid = threadIdx.x, wid = __builtin_amdgcn_readfirstlane(tid >> 6), lane = tid & 63, wr = wid >> 2, wc = wid & 3, fr = lane & 15, fq = lane >> 4;
    const int K = g.K, nt = K / BK;
    unsigned voffA[2], voffB[2];
#pragma unroll
    for (int i = 0; i < 2; ++i) { int R, C; stage_rc(tid * 16 + i * 8192, R, C); const int Rb = Epi::PERM ? ((R & ~31) + perm32(R & 31)) : R;
        voffA[i] = (unsigned)(R * K + C) * 2u; voffB[i] = (unsigned)(Rb * K + C) * 2u; }
    const size_t kstep = (size_t)(BK * 2);
    const size_t hstep = (size_t)HALF * K * 2;
    const size_t tstep = 2 * hstep;
    const unsigned ldsw = (unsigned)wid * 1024u;
    const int aoff = lds_byte(wr * 64 + fr, fq * 8), boff = lds_byte(wc * 32 + fr, fq * 8);
#define PG8_SA(b, h) (((b) * 2 + (h)) * HTB)
#define PG8_SB(b, h) ((4 + (b) * 2 + (h)) * HTB)
#define PG8_STAGE(bufoff, gbase, voff) do { _Pragma("unroll") for (int _i = 0; _i < 2; ++_i) \
        __builtin_amdgcn_global_load_lds((const unsigned*)((const char*)(gbase) + (voff)[_i]), (PG8_LAS unsigned*)(lds + (bufoff) + ldsw + _i * 8192), 16, 0, 0); } while (0)
#define PG8_LDA(dst, b, h) do { _Pragma("unroll") for (int m = 0; m < 4; ++m) _Pragma("unroll") for (int k = 0; k < 2; ++k) dst[m][k] = *(const PG8_LAS bf16x8*)(lds + PG8_SA(b, h) + aoff + m * 2048 + k * 1024); } while (0)
#define PG8_LDB(dst, b, h) do { _Pragma("unroll") for (int n = 0; n < 2; ++n) _Pragma("unroll") for (int k = 0; k < 2; ++k) dst[n][k] = *(const PG8_LAS bf16x8*)(lds + PG8_SB(b, h) + boff + n * 2048 + k * 1024); } while (0)
#define PG8_MMA(ai, bj, At, Bt) do { __builtin_amdgcn_s_setprio(1); _Pragma("unroll") for (int m = 0; m < 4; ++m) _Pragma("unroll") for (int n = 0; n < 2; ++n) _Pragma("unroll") for (int k = 0; k < 2; ++k) \
        acc[ai][bj][m][n] = __builtin_amdgcn_mfma_f32_16x16x32_bf16(Bt[n][k], At[m][k], acc[ai][bj][m][n], 0, 0, 0); __builtin_amdgcn_s_setprio(0); } while (0)
#define PG8_WAIT_V(n) asm volatile("s_waitcnt vmcnt(" #n ")" ::: "memory")
#define PG8_WAIT_L(n) asm volatile("s_waitcnt lgkmcnt(" #n ")" ::: "memory")
#define PG8_BAR __builtin_amdgcn_s_barrier()
#define PG8_SCHED __builtin_amdgcn_sched_barrier(0)
    Unit cur, nxt; int ui = 0;
    if (!S.next(0, cur)) return;
    f32x4 acc[2][2][4][2];
#pragma unroll
    for (int a = 0; a < 2; ++a)
#pragma unroll
        for (int b = 0; b < 2; ++b)
#pragma unroll
            for (int m = 0; m < 4; ++m)
#pragma unroll
                for (int n = 0; n < 2; ++n) acc[a][b][m][n] = (f32x4){0.f, 0.f, 0.f, 0.f};
    bf16x8 At[4][2], B0[2][2], B1[2][2];
    const char* cA = (const char*)g.A + (size_t)cur.pm * tstep; const char* cB = (const char*)g.Bt + (size_t)cur.pn * tstep;
    S.a_ready(cur);
    if constexpr (SP2) {
        PG8_STAGE(PG8_SB(0, 0), cB, voffB); PG8_STAGE(PG8_SB(0, 1), cB + hstep, voffB); PG8_STAGE(PG8_SA(0, 0), cA, voffA); PG8_STAGE(PG8_SA(0, 1), cA + hstep, voffA);
        if (wr == 1) PG8_BAR;
        PG8_WAIT_V(2); PG8_BAR;
        PG8_STAGE(PG8_SB(1, 0), cB + kstep, voffB); PG8_STAGE(PG8_SA(1, 0), cA + kstep, voffA); PG8_STAGE(PG8_SB(1, 1), cB + hstep + kstep, voffB);
        PG8_WAIT_V(6); PG8_BAR;
    } else {
        PG8_STAGE(PG8_SB(0, 0), cB, voffB); PG8_STAGE(PG8_SA(0, 0), cA, voffA); PG8_STAGE(PG8_SB(0, 1), cB + hstep, voffB); PG8_STAGE(PG8_SA(0, 1), cA + hstep, voffA);
        if (wr == 1) PG8_BAR;
        PG8_WAIT_V(4); PG8_BAR;
        PG8_STAGE(PG8_SB(1, 0), cB + kstep, voffB); PG8_STAGE(PG8_SA(1, 0), cA + kstep, voffA); PG8_STAGE(PG8_SB(1, 1), cB + hstep + kstep, voffB);
        PG8_WAIT_V(6); PG8_BAR;
    }
    for (;;) {
        const bool has_next = S.next(ui + 1, nxt);
        const char* nA = has_next ? (const char*)g.A + (size_t)nxt.pm * tstep : cA; const char* nB = has_next ? (const char*)g.Bt + (size_t)nxt.pn * tstep : cB;
        for (int t = 0; t < nt; t += 2) {
            const bool last = (t == nt - 2);
            const char* a1 = cA + (size_t)(t + 1) * kstep;
            const char* a2 = last ? nA : cA + (size_t)(t + 2) * kstep; const char* b2 = last ? nB : cB + (size_t)(t + 2) * kstep;
            const char* a3 = a2 + kstep; const char* b3 = b2 + kstep;
            if (last && has_next) S.a_ready(nxt);
            if constexpr (SP2) {
            PG8_LDB(B0, 0, 0); PG8_LDB(B1, 0, 1); PG8_SCHED; PG8_LDA(At, 0, 0); PG8_STAGE(PG8_SA(1, 1), a1 + hstep, voffA);
            PG8_WAIT_V(8); PG8_WAIT_L(0); PG8_BAR; PG8_MMA(0, 0, At, B0); PG8_MMA(0, 1, At, B1); PG8_BAR; PG8_SCHED;
            PG8_LDA(At, 0, 1); PG8_STAGE(PG8_SB(0, 0), b2, voffB); PG8_STAGE(PG8_SB(0, 1), b2 + hstep, voffB); PG8_STAGE(PG8_SA(0, 0), a2, voffA);
            PG8_WAIT_V(8); PG8_WAIT_L(0); PG8_BAR; PG8_MMA(1, 0, At, B0); PG8_MMA(1, 1, At, B1); PG8_BAR; PG8_SCHED;
            PG8_LDB(B0, 1, 0); PG8_LDB(B1, 1, 1); PG8_SCHED; PG8_LDA(At, 1, 0); PG8_STAGE(PG8_SA(0, 1), a2 + hstep, voffA);
            PG8_WAIT_V(8); PG8_WAIT_L(0); PG8_BAR; PG8_MMA(0, 0, At, B0); PG8_MMA(0, 1, At, B1); PG8_BAR; PG8_SCHED;
            PG8_LDA(At, 1, 1); PG8_STAGE(PG8_SB(1, 0), b3, voffB); PG8_STAGE(PG8_SB(1, 1), b3 + hstep, voffB); PG8_STAGE(PG8_SA(1, 0), a3, voffA);
            PG8_WAIT_V(8); PG8_WAIT_L(0); PG8_BAR; PG8_MMA(1, 0, At, B0); PG8_MMA(1, 1, At, B1); PG8_BAR; PG8_SCHED;
            } else {
            PG8_LDB(B0, 0, 0); PG8_SCHED; PG8_LDA(At, 0, 0); PG8_STAGE(PG8_SA(1, 1), a1 + hstep, voffA);
            PG8_WAIT_L(8); PG8_BAR; PG8_WAIT_L(0); PG8_MMA(0, 0, At, B0); PG8_BAR; PG8_SCHED;
            PG8_LDB(B1, 0, 1); PG8_STAGE(PG8_SB(0, 0), b2, voffB);
            PG8_BAR; PG8_WAIT_L(0); PG8_MMA(0, 1, At, B1); PG8_BAR;
            PG8_LDA(At, 0, 1); PG8_STAGE(PG8_SA(0, 0), a2, voffA);
            PG8_BAR; PG8_WAIT_L(0); PG8_MMA(1, 0, At, B0); PG8_BAR; PG8_SCHED;
            PG8_STAGE(PG8_SB(0, 1), b2 + hstep, voffB);
            PG8_WAIT_V(6); PG8_BAR; PG8_MMA(1, 1, At, B1); PG8_BAR;
            PG8_LDB(B0, 1, 0); PG8_SCHED; PG8_LDA(At, 1, 0); PG8_STAGE(PG8_SA(0, 1), a2 + hstep, voffA);
            PG8_WAIT_L(8); PG8_BAR; PG8_WAIT_L(0); PG8_MMA(0, 0, At, B0); PG8_BAR; PG8_SCHED;
            PG8_LDB(B1, 1, 1); PG8_STAGE(PG8_SB(1, 0), b3, voffB);
            PG8_BAR; PG8_WAIT_L(0); PG8_MMA(0, 1, At, B1); PG8_BAR;
            PG8_LDA(At, 1, 1); PG8_STAGE(PG8_SA(1, 0), a3, voffA);
            PG8_BAR; PG8_WAIT_L(0); PG8_MMA(1, 0, At, B0); PG8_BAR; PG8_SCHED;
            PG8_STAGE(PG8_SB(1, 1), b3 + hstep, voffB);
            PG8_WAIT_V(6); PG8_BAR; PG8_MMA(1, 1, At, B1); PG8_BAR;
            }
        }
        if constexpr (ALIGN_EPI) { if (wr == 0) PG8_BAR; }
        if constexpr (!Epi::AFTER_DRAIN) { E(acc, cur, wr, wc, fr, fq); S.done(cur); }
        if (!has_next) break;
#pragma unroll
        for (int a = 0; a < 2; ++a)
#pragma unroll
            for (int b = 0; b < 2; ++b)
#pragma unroll
                for (int m = 0; m < 4; ++m)
#pragma unroll
                    for (int n = 0; n < 2; ++n) acc[a][b][m][n] = (f32x4){0.f, 0.f, 0.f, 0.f};
        cur = nxt; cA = nA; cB = nB; ++ui;
        if constexpr (ALIGN_EPI) { if (wr == 1) PG8_BAR; }
    }
    PG8_WAIT_V(0);
    if constexpr (!ALIGN_EPI) { if (wr == 0) PG8_BAR; }
    PG8_BAR;
    if constexpr (Epi::AFTER_DRAIN) { E.fused(acc, cur, wr, wc, fr, fq, lds, wid, lane); S.done(cur); }
#undef PG8_SA
#undef PG8_SB
#undef PG8_STAGE
#undef PG8_LDA
#undef PG8_LDB
#undef PG8_MMA
#undef PG8_WAIT_V
#undef PG8_WAIT_L
#undef PG8_BAR
#undef PG8_SCHED
}
}
#define GAS __attribute__((address_space(1)))
#define LAS __attribute__((address_space(3)))
typedef unsigned short bf16;
typedef unsigned v4u __attribute__((ext_vector_type(4)));
typedef float f32x4 __attribute__((ext_vector_type(4)));
typedef short bf16x8 __attribute__((ext_vector_type(8)));
typedef GAS unsigned gu32;
typedef GAS unsigned long long gu64;
#define RLX_AGENT __ATOMIC_RELAXED, __HIP_MEMORY_SCOPE_AGENT
#define LDS_WAIT() asm volatile("s_waitcnt lgkmcnt(0)" ::: "memory")
#define VM_WAIT() asm volatile("s_waitcnt vmcnt(0)" ::: "memory")
__device__ __forceinline__ unsigned long long rt() { return __builtin_amdgcn_s_memrealtime(); }
__device__ __forceinline__ unsigned f2bf(float f) { unsigned u = __builtin_bit_cast(unsigned, f); return (u + 0x7fffu + ((u >> 16) & 1u)) >> 16; }
__device__ __forceinline__ unsigned pk2(float lo, float hi) { return f2bf(lo) | (f2bf(hi) << 16); }

#define XB_TMO      128
#define XB_XCNT(j)  (256  + 64 * (j))
#define XB_XSUB(j)  (1280 + 64 * (j))
#define XB_XGEN(j)  (2304 + 64 * (j))
#define XB_TOP      3328
#define XB_TOPGEN   3392
#define XCD_BAR_WORDS 3456
#define XB_SPIN_CAP (1u << 18)

__device__ __forceinline__ unsigned xb_ld(unsigned* p)              { return __hip_atomic_load(p, __ATOMIC_RELAXED, __HIP_MEMORY_SCOPE_AGENT); }
__device__ __forceinline__ unsigned xb_add(unsigned* p, unsigned v) { return __hip_atomic_fetch_add(p, v, __ATOMIC_RELAXED, __HIP_MEMORY_SCOPE_AGENT); }
__device__ __forceinline__ unsigned xb_xcc_id() { return (unsigned)__builtin_amdgcn_s_getreg((3 << 11) | 20) & 0xFu; }
#define XB_SPIN(cond, bar) do { unsigned _sp = 0; while (cond) { __builtin_amdgcn_s_sleep(1); \
    if ((++_sp & 255u) == 0u) { if (xb_ld(&(bar)[XB_TMO])) break; if (_sp > XB_SPIN_CAP) { atomicAdd(&(bar)[XB_TMO], 1u); break; } } } } while (0)

struct XcdBarrier {
    unsigned* bar; unsigned x;
    volatile LAS unsigned* st;
};

__device__ __forceinline__ XcdBarrier xcd_barrier_post(unsigned* bar, volatile LAS unsigned* st) {
    XcdBarrier b; b.bar = bar; b.x = xb_xcc_id(); b.st = st;
    if (threadIdx.x == 0) (void)xb_add(&bar[XB_XCNT(b.x)], 1u);
    return b;
}
__device__ __forceinline__ void xcd_barrier_complete(unsigned* bar, unsigned x, unsigned& nloc, unsigned& nx) {
    const unsigned G = gridDim.x * gridDim.y * gridDim.z;
    unsigned sum, cnt, mine, sp = 0u;
    for (;;) {
        sum = 0u; cnt = 0u; mine = 0u;
#pragma unroll
        for (unsigned j = 0; j < 16; ++j) { const unsigned c = xb_ld(&bar[XB_XCNT(j)]); sum += c; cnt += (c > 0u) ? 1u : 0u; mine = (j == x) ? c : mine; }
        if (sum == G) break;
        __builtin_amdgcn_s_sleep(1);
        if ((++sp & 255u) == 0u) { if (xb_ld(&bar[XB_TMO])) break; if (sp > XB_SPIN_CAP) { atomicAdd(&bar[XB_TMO], 1u); break; } }
    }
    nloc = mine > 0u ? mine : 1u; nx = cnt > 0u ? cnt : 1u;
}

__device__ __forceinline__ void xcd_barrier(const XcdBarrier& b) {
    asm volatile("s_waitcnt vmcnt(0)" ::: "memory");
    __syncthreads();
    if (threadIdx.x == 0) {
        unsigned* bar = b.bar;
        __builtin_amdgcn_s_waitcnt(0);
        unsigned nloc = b.st[0], nx = b.st[1];
        if (nloc == 0u) { xcd_barrier_complete(bar, b.x, nloc, nx); b.st[0] = nloc; b.st[1] = nx; }
        const unsigned old = xb_add(&bar[XB_XSUB(b.x)], 1u);
        const unsigned gen = old / nloc;
        if (old + 1u == (gen + 1u) * nloc) {
            __builtin_amdgcn_fence(__ATOMIC_RELEASE, "agent");
            asm volatile("s_waitcnt vmcnt(0)" ::: "memory");
            const unsigned og = xb_add(&bar[XB_TOP], 1u);
            const unsigned tg = og / nx;
            if (og + 1u == (tg + 1u) * nx) xb_add(&bar[XB_TOPGEN], 1u);
            else XB_SPIN(xb_ld(&bar[XB_TOPGEN]) == tg, bar);
            __builtin_amdgcn_fence(__ATOMIC_ACQUIRE, "agent");
            xb_add(&bar[XB_XGEN(b.x)], 1u);
            asm volatile("s_waitcnt vmcnt(0)" ::: "memory");
        } else {
            XB_SPIN(xb_ld(&bar[XB_XGEN(b.x)]) == gen, bar);
            __builtin_amdgcn_fence(__ATOMIC_ACQUIRE, "agent");
            asm volatile("s_waitcnt vmcnt(0)" ::: "memory");
        }
    }
    __syncthreads();
}

constexpr int DM = 1024, SEQ = 8192, PB = 4, SB = 128, ST = 4, LBUF = 2048;
constexpr int NP = PB * SEQ;
constexpr int NS = SB * ST;
constexpr int MT = NP + NS;
constexpr int DIN = 4104, NPROJ = 4096;
constexpr int CONVCH = 1536;
constexpr int PC_ZA = 1536, PC_QB = 2048, PC_KB = 2560, PC_VB = 3072, PC_ZB = 3584;
constexpr float NORM_EPS = 1e-6f;
constexpr size_t O_YP = 0, O_YS = (size_t)NP * DM, O_CONVP = O_YS + (size_t)NS * DM, O_DELTAP = O_CONVP + (size_t)PB * 3 * CONVCH,
                 O_KWP = O_DELTAP + (size_t)PB * 4 * 128 * 128, O_VWP = O_KWP + (size_t)PB * LBUF * 512, O_CONVS = O_VWP + (size_t)PB * LBUF * 512,
                 O_DELTAS = O_CONVS + (size_t)SB * 3 * CONVCH, O_KWS = O_DELTAS + (size_t)SB * 4 * 128 * 128, O_VWS = O_KWS + (size_t)SB * LBUF * 512,
                 O_END = O_VWS + (size_t)SB * LBUF * 512;
constexpr size_t MiB = 1u << 20;
constexpr size_t WS_CTL = 0, CTL_ZERO_BYTES = 1 * MiB;
constexpr size_t WS_WIN = 2 * MiB, WS_WOUT = 10 * MiB, WS_GB = 12 * MiB, WS_XN = 16 * MiB, WS_PROJ = 96 * MiB, WS_OA = 360 * MiB, WS_MIX = 432 * MiB, WS_END = 512 * MiB;
constexpr int CW_TMO = 0, CW_BAR = 4096;
constexpr int LDS_BYTES = 147456, RING_BYTES = 131072, LDSCTL_OFF = RING_BYTES, MISC_OFF = LDSCTL_OFF + 320;
constexpr int NWAVES = 8, NTHR = 512;

struct Args { const float* in[14]; float* out; unsigned char* ws; int ph_lo, ph_hi; };
enum { I_XP = 0, I_XS, I_SCONV, I_SDELTA, I_CK, I_CV, I_NORMG, I_FNORMG, I_WIN, I_CONVW, I_ALOG, I_DTB, I_DNG, I_WOUT };

struct Frame {
    LAS unsigned char* lds;
    int tid, lane, wave, G;
    const float* in[14]; float* out; unsigned char* ws;
    bf16 *WinT, *WoutT, *XN, *PROJ, *MIX; float *GB, *OA;
};

__device__ __forceinline__ float wave_sum(float v) {
#pragma unroll
    for (int o = 1; o < 64; o <<= 1) v += __shfl_xor(v, o);
    return v;
}
__device__ __forceinline__ float bf2f(bf16 v) { return __uint_as_float((unsigned)v << 16); }
__device__ __forceinline__ float bflo(unsigned w) { return __uint_as_float(w << 16); }
__device__ __forceinline__ float bfhi(unsigned w) { return __uint_as_float(w & 0xffff0000u); }
__device__ __forceinline__ float siluf(float y) { return y / (1.f + __expf(-y)); }

__device__ __forceinline__ void p0_transpose_item(const float* W, int K, int ldw, int c0, bf16* WT, int n0, int k0, LAS float* scr, int lane) {
#pragma unroll 8
    for (int i = 0; i < 32; ++i) { const int kk = 2 * i + (lane >> 5); scr[kk * 33 + (lane & 31)] = W[(size_t)(k0 + kk) * ldw + c0 + (lane & 31)]; }
    LDS_WAIT(); asm volatile("" ::: "memory");
    const int c = lane & 7;
#pragma unroll
    for (int j = 0; j < 4; ++j) { const int n = (lane >> 3) + 8 * j; const LAS float* s = scr + (8 * c) * 33 + n;
        v4u o; o.x = pk2(s[0 * 33], s[1 * 33]); o.y = pk2(s[2 * 33], s[3 * 33]); o.z = pk2(s[4 * 33], s[5 * 33]); o.w = pk2(s[6 * 33], s[7 * 33]);
        *(GAS v4u*)(WT + (size_t)(n0 + n) * K + k0 + 8 * c) = o; }
    LDS_WAIT(); asm volatile("" ::: "memory");
}
__device__ __forceinline__ void p0_prologue(Frame& F) {
    LAS float* W8T = (LAS float*)(F.lds);
    const float* w_in = F.in[I_WIN];
    for (int i = F.tid; i < 8 * 1024; i += NTHR) { const int k = i >> 3, e = i & 7; W8T[e * 1024 + k] = w_in[(size_t)k * DIN + 2048 + e]; }
    __syncthreads();
    const int gw = blockIdx.x * NWAVES + F.wave, NGW = F.G * NWAVES;
    const float* ng = F.in[I_NORMG];
    f32x4 gv[4];
#pragma unroll
    for (int j = 0; j < 4; ++j) gv[j] = *(const f32x4*)(ng + 4 * F.lane + 256 * j);
    const float a_log_l = (F.lane < 4) ? F.in[I_ALOG][F.lane] : 0.f, dtb_l = (F.lane < 4) ? F.in[I_DTB][F.lane] : 0.f;
    for (int m = gw; m < MT; m += NGW) {
        const float* xrow = (m < NP) ? F.in[I_XP] + (size_t)m * DM : F.in[I_XS] + (size_t)(m - NP) * DM;
        const GAS f32x4* xr = (const GAS f32x4*)xrow + F.lane;
        f32x4 v[4]; float s = 0.f;
#pragma unroll
        for (int j = 0; j < 4; ++j) { v[j] = xr[64 * j]; s += (v[j].x * v[j].x + v[j].y * v[j].y) + (v[j].z * v[j].z + v[j].w * v[j].w); }
        const float rs = 1.f / sqrtf(wave_sum(s) * (1.f / DM) + NORM_EPS);
#pragma unroll
        for (int j = 0; j < 4; ++j) v[j] = v[j] * rs * gv[j];
        GAS unsigned long long* o8 = (GAS unsigned long long*)(F.XN + (size_t)m * DM) + F.lane;
#pragma unroll
        for (int j = 0; j < 4; ++j) o8[64 * j] = (unsigned long long)pk2(v[j].x, v[j].y) | ((unsigned long long)pk2(v[j].z, v[j].w) << 32);
        float d[8];
#pragma unroll
        for (int e = 0; e < 8; ++e) { float acc = 0.f;
#pragma unroll
            for (int j = 0; j < 4; ++j) { const f32x4 w = *(const LAS f32x4*)(W8T + e * 1024 + 4 * F.lane + 256 * j); acc += (v[j].x * w.x + v[j].y * w.y) + (v[j].z * w.z + v[j].w * w.w); }
            d[e] = wave_sum(acc); }
        float mine = 0.f;
#pragma unroll
        for (int e = 0; e < 8; ++e) mine = (F.lane == e) ? d[e] : mine;
        if (F.lane < 4) { const float xx = mine + dtb_l; const float sp = xx > 20.f ? xx : log1pf(expf(xx)); F.GB[(size_t)m * 8 + F.lane] = -expf(a_log_l) * sp; }
        else if (F.lane < 8) { F.GB[(size_t)m * 8 + F.lane] = 1.f / (1.f + expf(-mine)); }
    }
    __syncthreads();
    LAS float* scr = (LAS float*)(F.lds + 32768 + F.wave * 8448);
    constexpr int I_IN = (DM / 64) * (NPROJ / 32), I_OUT = (DM / 64) * (DM / 32);
    for (int it = gw; it < I_IN + I_OUT; it += NGW) {
        if (it < I_IN) { const int kb = it / (NPROJ / 32), nb = it % (NPROJ / 32), n0 = nb * 32; p0_transpose_item(w_in, DM, DIN, n0 + (n0 >= 2048 ? 8 : 0), F.WinT, n0, kb * 64, scr, F.lane); }
        else { const int r = it - I_IN, kb = r / (DM / 32), nb = r % (DM / 32); p0_transpose_item(F.in[I_WOUT], DM, DM, nb * 32, F.WoutT, nb * 32, kb * 64, scr, F.lane); }
    }
}

__device__ __forceinline__ void dn_seq_unit(Frame& F, int unit) {
    LAS float* cv = (LAS float*)F.lds;
    LAS float* part = cv + 384;
    LAS float* psum = cv + 512;
    LAS float* osum = cv + 1024;
    const int t = F.tid, dv = t & 127, qd = t >> 7;
    int L, row0, h; const float* prefix; const float* S0; float* Sout;
    if (unit < 16) { const int b = unit >> 2; h = unit & 3; L = SEQ; row0 = b * SEQ; prefix = nullptr; S0 = nullptr; Sout = F.out + O_DELTAP + (size_t)unit * 16384; }
    else { const int u = unit - 16, b = u >> 2; h = u & 3; L = ST; row0 = NP + b * ST; prefix = F.in[I_SCONV] + (size_t)b * 3 * CONVCH; S0 = F.in[I_SDELTA] + (size_t)u * 16384; Sout = F.out + O_DELTAS + (size_t)u * 16384; }
    float S[32];
#pragma unroll
    for (int i = 0; i < 32; ++i) S[i] = S0 ? S0[(size_t)(qd * 32 + i) * 128 + dv] : 0.f;
    const int which = t >> 7, ch = t & 127, gcol = (which < 3 ? which : 0) * 512 + h * 128 + ch;
    float w0 = 0.f, w1 = 0.f, w2 = 0.f, w3 = 0.f, x0 = 0.f, x1 = 0.f, x2 = 0.f;
    if (t < 384) { const float* cw = F.in[I_CONVW]; w0 = cw[gcol]; w1 = cw[CONVCH + gcol]; w2 = cw[2 * CONVCH + gcol]; w3 = cw[3 * CONVCH + gcol];
        if (prefix) { x0 = prefix[gcol]; x1 = prefix[CONVCH + gcol]; x2 = prefix[2 * CONVCH + gcol]; } }
    __syncthreads();
    for (int tau = 0; tau < L; ++tau) {
        const size_t row = (size_t)(row0 + tau);
        float ss = 0.f;
        if (t < 384) { const float x3 = bf2f(F.PROJ[row * NPROJ + gcol]); float y = w0 * x0 + w1 * x1 + w2 * x2 + w3 * x3; x0 = x1; x1 = x2; x2 = x3; y = siluf(y); cv[t] = y; ss = (t < 256) ? y * y : 0.f; }
        if (F.wave < 4) { ss = wave_sum(ss); if (F.lane == 0) part[F.wave] = ss; }
        __syncthreads();
        const float qn = (1.f / sqrtf(part[0] + part[1] + NORM_EPS)) * 0.08838834764831845f, kn = 1.f / sqrtf(part[2] + part[3] + NORM_EPS);
        const float g = F.GB[row * 8 + h], beta = F.GB[row * 8 + 4 + h], a = expf(g);
        float p = 0.f;
#pragma unroll
        for (int i = 0; i < 32; ++i) { S[i] *= a; p += S[i] * cv[128 + qd * 32 + i]; }
        psum[qd * 128 + dv] = p * kn;
        __syncthreads();
        const float ptot = (psum[dv] + psum[128 + dv]) + (psum[256 + dv] + psum[384 + dv]);
        const float r = beta * (cv[256 + dv] - ptot);
        float o = 0.f;
#pragma unroll
        for (int i = 0; i < 32; ++i) { S[i] += (cv[128 + qd * 32 + i] * kn) * r; o += S[i] * cv[qd * 32 + i]; }
        osum[qd * 128 + dv] = o * qn;
        __syncthreads();
        if (qd == 0) F.OA[row * 512 + h * 128 + dv] = (osum[dv] + osum[128 + dv]) + (osum[256 + dv] + osum[384 + dv]);
    }
#pragma unroll
    for (int i = 0; i < 32; ++i) Sout[(size_t)(qd * 32 + i) * 128 + dv] = S[i];
    __syncthreads();
}

__device__ __forceinline__ void ld_bf16x64(const bf16* p, float (&v)[64]) {
    const v4u* p4 = (const v4u*)p;
#pragma unroll
    for (int i = 0; i < 8; ++i) { const v4u w = p4[i]; v[8 * i] = bflo(w.x); v[8 * i + 1] = bfhi(w.x); v[8 * i + 2] = bflo(w.y); v[8 * i + 3] = bfhi(w.y); v[8 * i + 4] = bflo(w.z); v[8 * i + 5] = bfhi(w.z); v[8 * i + 6] = bflo(w.w); v[8 * i + 7] = bfhi(w.w); }
}
__device__ __forceinline__ float dot_bf16row(const bf16* p, const float (&q)[64]) {
    const v4u* p4 = (const v4u*)p; float s = 0.f;
#pragma unroll
    for (int i = 0; i < 8; ++i) { const v4u w = p4[i]; s += q[8 * i] * bflo(w.x) + q[8 * i + 1] * bfhi(w.x) + q[8 * i + 2] * bflo(w.y) + q[8 * i + 3] * bfhi(w.y) + q[8 * i + 4] * bflo(w.z) + q[8 * i + 5] * bfhi(w.z) + q[8 * i + 6] * bflo(w.w) + q[8 * i + 7] * bfhi(w.w); }
    return s;
}
__device__ __forceinline__ void axpy_bf16row(const bf16* p, float a, float sc, float (&o)[64]) {
    const v4u* p4 = (const v4u*)p;
#pragma unroll
    for (int i = 0; i < 8; ++i) { const v4u w = p4[i];
        o[8 * i] = o[8 * i] * sc + a * bflo(w.x); o[8 * i + 1] = o[8 * i + 1] * sc + a * bfhi(w.x); o[8 * i + 2] = o[8 * i + 2] * sc + a * bflo(w.y); o[8 * i + 3] = o[8 * i + 3] * sc + a * bfhi(w.y);
        o[8 * i + 4] = o[8 * i + 4] * sc + a * bflo(w.z); o[8 * i + 5] = o[8 * i + 5] * sc + a * bfhi(w.z); o[8 * i + 6] = o[8 * i + 6] * sc + a * bflo(w.w); o[8 * i + 7] = o[8 * i + 7] * sc + a * bfhi(w.w); }
}
__device__ __forceinline__ float dot_f32row(const float* p, const float (&q)[64]) {
    const f32x4* p4 = (const f32x4*)p; float s = 0.f;
#pragma unroll
    for (int i = 0; i < 16; ++i) { const f32x4 w = p4[i]; s += q[4 * i] * w.x + q[4 * i + 1] * w.y + q[4 * i + 2] * w.z + q[4 * i + 3] * w.w; }
    return s;
}
__device__ __forceinline__ void axpy_f32row(const float* p, float a, float sc, float (&o)[64]) {
    const f32x4* p4 = (const f32x4*)p;
#pragma unroll
    for (int i = 0; i < 16; ++i) { const f32x4 w = p4[i]; o[4 * i] = o[4 * i] * sc + a * w.x; o[4 * i + 1] = o[4 * i + 1] * sc + a * w.y; o[4 * i + 2] = o[4 * i + 2] * sc + a * w.z; o[4 * i + 3] = o[4 * i + 3] * sc + a * w.w; }
}
__device__ __forceinline__ void attn_write(Frame& F, size_t row, int h, const float (&o)[64], float l) {
    float z[64]; ld_bf16x64(F.PROJ + row * NPROJ + PC_ZB + h * 64, z);
    const float il = 1.f / l;
    v4u* dst = (v4u*)(F.MIX + row * DM + 512 + h * 64);
#pragma unroll
    for (int i = 0; i < 8; ++i) { v4u w; w.x = pk2(o[8 * i] * il * siluf(z[8 * i]), o[8 * i + 1] * il * siluf(z[8 * i + 1])); w.y = pk2(o[8 * i + 2] * il * siluf(z[8 * i + 2]), o[8 * i + 3] * il * siluf(z[8 * i + 3]));
        w.z = pk2(o[8 * i + 4] * il * siluf(z[8 * i + 4]), o[8 * i + 5] * il * siluf(z[8 * i + 5])); w.w = pk2(o[8 * i + 6] * il * siluf(z[8 * i + 6]), o[8 * i + 7] * il * siluf(z[8 * i + 7])); dst[i] = w; }
}
__device__ __forceinline__ void attn_simple(Frame& F) {
    const int gt = blockIdx.x * NTHR + F.tid, NGT = F.G * NTHR;
    for (int it = gt; it < PB * 8 * SEQ; it += NGT) {
        const int bh = it >> 13, pos = it & (SEQ - 1), b = bh >> 3, h = bh & 7; const size_t row = (size_t)b * SEQ + pos;
        float q[64]; ld_bf16x64(F.PROJ + row * NPROJ + PC_QB + h * 64, q);
#pragma unroll
        for (int i = 0; i < 64; ++i) q[i] *= 0.125f;
        float o[64];
#pragma unroll
        for (int i = 0; i < 64; ++i) o[i] = 0.f;
        float m = -INFINITY, l = 0.f;
        for (int br = 0; br < 3; ++br) { const int d = br == 0 ? 1 : (br == 1 ? 4 : 16);
            for (int j = 0; j <= 128; ++j) { const int kp = pos - d * j; if (kp < 0) break;
                const bf16* kr = F.PROJ + ((size_t)b * SEQ + kp) * NPROJ + h * 64;
                const float s = dot_bf16row(kr + PC_KB, q); const float mn = fmaxf(m, s), sc = __expf(m - mn), p = __expf(s - mn);
                l = l * sc + p; axpy_bf16row(kr + PC_VB, p, sc, o); m = mn; } }
        attn_write(F, row, h, o, l);
    }
    for (int it = gt; it < SB * 8 * ST; it += NGT) {
        const int t = it & 3, bh = it >> 2, b = bh >> 3, h = bh & 7; const size_t row = (size_t)NP + b * ST + t;
        float q[64]; ld_bf16x64(F.PROJ + row * NPROJ + PC_QB + h * 64, q);
#pragma unroll
        for (int i = 0; i < 64; ++i) q[i] *= 0.125f;
        float o[64];
#pragma unroll
        for (int i = 0; i < 64; ++i) o[i] = 0.f;
        float m = -INFINITY, l = 0.f;
        for (int br = 0; br < 3; ++br) { const int d = br == 0 ? 1 : (br == 1 ? 4 : 16);
            for (int j = 0; j <= 128; ++j) { const int idx = LBUF + t - d * j; if (idx < 0) break;
                float s;
                if (idx >= LBUF) { const bf16* kr = F.PROJ + ((size_t)NP + b * ST + (idx - LBUF)) * NPROJ + h * 64; s = dot_bf16row(kr + PC_KB, q);
                    const float mn = fmaxf(m, s), sc = __expf(m - mn), p = __expf(s - mn); l = l * sc + p; axpy_bf16row(kr + PC_VB, p, sc, o); m = mn; }
                else { const size_t off = ((size_t)b * LBUF + idx) * 512 + h * 64; s = dot_f32row(F.in[I_CK] + off, q);
                    const float mn = fmaxf(m, s), sc = __expf(m - mn), p = __expf(s - mn); l = l * sc + p; axpy_f32row(F.in[I_CV] + off, p, sc, o); m = mn; } } }
        attn_write(F, row, h, o, l);
    }
}

__device__ __forceinline__ f32x4 ld4bf(const bf16* p) { const unsigned long long w = *(const unsigned long long*)p; return (f32x4){bflo((unsigned)w), bfhi((unsigned)w), bflo((unsigned)(w >> 32)), bfhi((unsigned)(w >> 32))}; }
__device__ __forceinline__ void copy_outputs(Frame& F) {
    const size_t gt = (size_t)blockIdx.x * NTHR + F.tid, NGT = (size_t)F.G * NTHR;
    for (size_t i = gt; i < ((size_t)2 << 25); i += NGT) {
        const int which = (int)(i >> 25); const size_t rem = i & (((size_t)1 << 25) - 1); const int b = (int)(rem >> 18), w = (int)(rem & ((1 << 18) - 1)), r = w >> 7, c4 = w & 127;
        f32x4 v;
        if (r < LBUF - ST) v = *(const f32x4*)(F.in[which ? I_CV : I_CK] + ((size_t)b * LBUF + r + ST) * 512 + c4 * 4);
        else v = ld4bf(F.PROJ + ((size_t)NP + b * ST + (r - (LBUF - ST))) * NPROJ + (which ? PC_VB : PC_KB) + c4 * 4);
        *(f32x4*)(F.out + (which ? O_VWS : O_KWS) + rem * 4) = v;
    }
    for (size_t i = gt; i < ((size_t)2 << 20); i += NGT) {
        const int which = (int)(i >> 20); const size_t rem = i & (((size_t)1 << 20) - 1); const int b = (int)(rem >> 18), w = (int)(rem & ((1 << 18) - 1)), r = w >> 7, c4 = w & 127;
        *(f32x4*)(F.out + (which ? O_VWP : O_KWP) + rem * 4) = ld4bf(F.PROJ + ((size_t)b * SEQ + (SEQ - LBUF) + r) * NPROJ + (which ? PC_VB : PC_KB) + c4 * 4);
    }
    for (size_t i = gt; i < (size_t)(PB + SB) * 3 * (CONVCH / 4); i += NGT) {
        const int c4 = (int)(i % (CONVCH / 4)), rr = (int)(i / (CONVCH / 4)), j = rr % 3, b = rr / 3;
        if (b < PB) *(f32x4*)(F.out + O_CONVP + ((size_t)b * 3 + j) * CONVCH + c4 * 4) = ld4bf(F.PROJ + ((size_t)b * SEQ + SEQ - 3 + j) * NPROJ + c4 * 4);
        else { const int bs = b - PB; *(f32x4*)(F.out + O_CONVS + ((size_t)bs * 3 + j) * CONVCH + c4 * 4) = ld4bf(F.PROJ + ((size_t)NP + bs * ST + 1 + j) * NPROJ + c4 * 4); }
    }
}

__device__ __forceinline__ void mix_a_finish(Frame& F) {
    const int gw = blockIdx.x * NWAVES + F.wave, NGW = F.G * NWAVES;
    const float g0 = F.in[I_DNG][2 * F.lane], g1 = F.in[I_DNG][2 * F.lane + 1];
    for (int it = gw; it < MT * 4; it += NGW) {
        const size_t row = (size_t)(it >> 2); const int h = it & 3;
        const float2 v = *(const float2*)(F.OA + row * 512 + h * 128 + 2 * F.lane);
        const float rs = 1.f / sqrtf(wave_sum(v.x * v.x + v.y * v.y) * (1.f / 128.f) + NORM_EPS);
        const unsigned zw = *(const unsigned*)(F.PROJ + row * NPROJ + PC_ZA + h * 128 + 2 * F.lane);
        *(unsigned*)(F.MIX + row * DM + h * 128 + 2 * F.lane) = pk2(v.x * rs * g0 * siluf(bflo(zw)), v.y * rs * g1 * siluf(bfhi(zw)));
    }
}
__device__ __forceinline__ void final_norm(Frame& F) {
    const int gw = blockIdx.x * NWAVES + F.wave, NGW = F.G * NWAVES;
    f32x4 gv[4];
#pragma unroll
    for (int j = 0; j < 4; ++j) gv[j] = *(const f32x4*)(F.in[I_FNORMG] + 4 * F.lane + 256 * j);
    for (int m = gw; m < MT; m += NGW) {
        GAS f32x4* yr = (GAS f32x4*)(F.out + (size_t)m * DM) + F.lane;
        f32x4 v[4]; float s = 0.f;
#pragma unroll
        for (int j = 0; j < 4; ++j) { v[j] = yr[64 * j]; s += (v[j].x * v[j].x + v[j].y * v[j].y) + (v[j].z * v[j].z + v[j].w * v[j].w); }
        const float rs = 1.f / sqrtf(wave_sum(s) * (1.f / DM) + NORM_EPS);
#pragma unroll
        for (int j = 0; j < 4; ++j) yr[64 * j] = v[j] * rs * gv[j];
    }
}

#ifndef MK_N_LAUNCHES
#define MK_N_LAUNCHES 1
#endif
constexpr int N_PHASES = 7, N_LAUNCHES = MK_N_LAUNCHES;
__global__ void __launch_bounds__(NTHR, 2) hymba_fwd(Args args) {
    extern __shared__ __attribute__((aligned(16))) unsigned char lds[];
    Frame F;
    F.lds = (LAS unsigned char*)lds;
    F.tid = threadIdx.x; F.lane = F.tid & 63; F.wave = __builtin_amdgcn_readfirstlane(F.tid >> 6); F.G = gridDim.x;
#pragma unroll
    for (int i = 0; i < 14; ++i) F.in[i] = args.in[i];
    F.out = args.out; F.ws = args.ws;
    F.WinT = (bf16*)(args.ws + WS_WIN); F.WoutT = (bf16*)(args.ws + WS_WOUT); F.XN = (bf16*)(args.ws + WS_XN); F.PROJ = (bf16*)(args.ws + WS_PROJ); F.MIX = (bf16*)(args.ws + WS_MIX);
    F.GB = (float*)(args.ws + WS_GB); F.OA = (float*)(args.ws + WS_OA);
    volatile LAS unsigned* MISC = (volatile LAS unsigned*)(F.lds + MISC_OFF);
    for (int u = F.tid; u < (LDS_BYTES - LDSCTL_OFF) / 4; u += NTHR) ((LAS unsigned*)(F.lds + LDSCTL_OFF))[u] = 0u;
    __syncthreads();
    unsigned* barw = (unsigned*)(args.ws + WS_CTL) + CW_BAR;
    XcdBarrier bar; bar.bar = barw; bar.x = 0; bar.st = nullptr;
    if (N_LAUNCHES == 1) bar = xcd_barrier_post(barw, MISC + 8);
    const int lo = args.ph_lo, hi = args.ph_hi;
#define IN(k) (lo <= (k) && (k) < hi)
#define BOTH(k) (IN(k) && IN((k) + 1))
#define GRID_BAR() do { if (N_LAUNCHES == 1) xcd_barrier(bar); } while (0)

    if (IN(0)) { p0_prologue(F); if (BOTH(0)) GRID_BAR(); }
    if (IN(1)) {
        pg8::Gemm g{F.XN, F.WinT, MT, NPROJ, DM}; pg8::StaticOrder S; S.init(MT, NPROJ, F.G, (int)blockIdx.x);
        pg8::EpiBf16 E{F.PROJ, NPROJ};
        pg8::gemm_phase<pg8::EpiBf16, pg8::StaticOrder, true, true>(F.lds, g, S, E);
        if (BOTH(1)) GRID_BAR();
    }
    if (IN(2)) {
        for (int u = blockIdx.x; u < 16 + SB * 4; u += F.G) dn_seq_unit(F, u);
        if (BOTH(2)) GRID_BAR();
    }
    if (IN(3)) { attn_simple(F); copy_outputs(F); if (BOTH(3)) GRID_BAR(); }
    if (IN(4)) { mix_a_finish(F); if (BOTH(4)) GRID_BAR(); }
    if (IN(5)) {
        pg8::Gemm g{F.MIX, F.WoutT, MT, DM, DM}; pg8::StaticOrder S; S.init(MT, DM, F.G, (int)blockIdx.x);
        pg8::EpiResF32 E{F.in[I_XP], F.in[I_XS], NP, F.out, DM};
        pg8::gemm_phase<pg8::EpiResF32, pg8::StaticOrder, true, true>(F.lds, g, S, E);
        if (BOTH(5)) GRID_BAR();
    }
    if (IN(6)) { final_norm(F); }
#undef IN
#undef BOTH
}

extern "C" void kernel_launch(void* const* d_in, const int* in_sizes, int n_in, void* d_out, int out_size, void* d_ws, size_t ws_size, hipStream_t stream) {
    static int grid = 0;
    if (grid == 0) {
        if (n_in != 14 || (size_t)out_size != O_END || ws_size < WS_END) { fprintf(stderr, "kernel_launch: unexpected shapes (n_in %d, out %d, ws %zu); nothing launched\n", n_in, out_size, ws_size); grid = -1; return; }
        int dev = 0, cus = 0, per_cu = 0;
        if (hipGetDevice(&dev) != hipSuccess || hipDeviceGetAttribute(&cus, hipDeviceAttributeMultiprocessorCount, dev) != hipSuccess) { grid = -1; return; }
        if (hipFuncSetAttribute((const void*)hymba_fwd, hipFuncAttributeMaxDynamicSharedMemorySize, LDS_BYTES) != hipSuccess) { fprintf(stderr, "kernel_launch: hipFuncSetAttribute failed\n"); grid = -1; return; }
        if (hipOccupancyMaxActiveBlocksPerMultiprocessor(&per_cu, (const void*)hymba_fwd, NTHR, LDS_BYTES) != hipSuccess || per_cu < 1) fprintf(stderr, "kernel_launch: occupancy query says %d\n", per_cu);
        (void)hipGetLastError();
        grid = cus;
    }
    if (grid < 0) return;
    if (hipMemsetAsync((char*)d_ws + WS_CTL, 0, CTL_ZERO_BYTES, stream) != hipSuccess) return;
    Args a{};
    for (int i = 0; i < 14; ++i) a.in[i] = (const float*)d_in[i];
    a.out = (float*)d_out; a.ws = (unsigned char*)d_ws;
    if (N_LAUNCHES == 1) { a.ph_lo = 0; a.ph_hi = N_PHASES; hipLaunchKernelGGL(hymba_fwd, dim3(grid), dim3(NTHR), LDS_BYTES, stream, a); }
    else for (int li = 0; li < N_PHASES; ++li) { a.ph_lo = li; a.ph_hi = li + 1; hipLaunchKernelGGL(hymba_fwd, dim3(grid), dim3(NTHR), LDS_BYTES, stream, a); }
}
```

```cpp
#include <hip/hip_runtime.h>
#include <cstdio>
#include <cstdint>
namespace pg8 {
#define PG8_LAS __attribute__((address_space(3)))
typedef unsigned short bf16_t;
typedef short bf16x8 __attribute__((ext_vector_type(8)));
typedef float f32x4 __attribute__((ext_vector_type(4)));
typedef unsigned u32x4 __attribute__((ext_vector_type(4)));
constexpr int BM = 256, BK = 64, HALF = 128, HTB = HALF * BK * 2  , STAGE_BYTES = 8 * HTB, NXCD = 8, WGM = 8;

__host__ __device__ __forceinline__ int lds_byte(int r, int c) { const int st = (r >> 4) * 2 + (c >> 5), rr = r & 15, cc = c & 31, ob = rr * 64 + cc * 2; return st * 1024 + (ob ^ (((ob >> 9) & 1) << 5)); }
__host__ __device__ __forceinline__ void stage_rc(int b, int& R, int& C) { const int st = b / 1024, sb = b % 1024, swz = sb ^ (((sb >> 9) & 1) << 5); R = (st >> 1) * 16 + swz / 64; C = (st & 1) * 32 + (swz % 64) / 2; }
__host__ __device__ __forceinline__ int perm32(int rho) { const int n = rho >> 4, i = rho & 15; return 8 * (i >> 2) + 4 * n + (i & 3); }

struct Unit { int pm, pn; };
struct Gemm { const bf16_t* A; const bf16_t* Bt; int M, N, K; };

struct StaticOrder {
    int nM, nN, nwg, G, c;
    __host__ __device__ void init(int M, int N, int G_, int c_) { nM = M / BM; nN = N / BM; nwg = nM * nN; G = G_; c = c_; }
    __host__ __device__ bool next(int i, Unit& u) const {
        const long L = (long)i * G + c; if (L >= nwg) return false;
        int wgid = (int)L; { const int q = nwg / NXCD, r = nwg % NXCD, xcd = wgid % NXCD, off = wgid / NXCD; wgid = (xcd < r ? xcd * (q + 1) : r * (q + 1) + (xcd - r) * q) + off; }
        const int nig = WGM * nN, gid = wgid / nig, fm = gid * WGM, gsz = (nM - fm) < WGM ? (nM - fm) : WGM;
        u.pm = fm + ((wgid % nig) % gsz); u.pn = (wgid % nig) / gsz; return true;
    }
    __device__ __forceinline__ void a_ready(const Unit&) const {}
    __device__ __forceinline__ void done(const Unit&) const {}
};

__device__ __forceinline__ unsigned cvt_pk_bf16(float lo, float hi) { unsigned r; asm volatile("v_cvt_pk_bf16_f32 %0, %1, %2" : "=v"(r) : "v"(lo), "v"(hi)); return r; }
typedef float f32x2 __attribute__((ext_vector_type(2)));
struct EpiBf16 {
    static constexpr bool PERM = true, AFTER_DRAIN = false;
    bf16_t* O; int ldc;
    __device__ __forceinline__ void operator()(const f32x4 (&acc)[2][2][4][2], const Unit& u, int wr, int wc, int fr, int fq) const {
        const int row0 = u.pm * BM + wr * 64 + fr; const int col0 = u.pn * BM + wc * 32 + 8 * fq;
#pragma unroll
        for (int ai = 0; ai < 2; ++ai)
#pragma unroll
            for (int m = 0; m < 4; ++m) { bf16_t* rowp = O + (size_t)(row0 + ai * HALF + m * 16) * ldc + col0;
#pragma unroll
                for (int bj = 0; bj < 2; ++bj) { const f32x4 v0 = acc[ai][bj][m][0], v1 = acc[ai][bj][m][1];
                    u32x4 w; w.x = cvt_pk_bf16(v0[0], v0[1]); w.y = cvt_pk_bf16(v0[2], v0[3]); w.z = cvt_pk_bf16(v1[0], v1[1]); w.w = cvt_pk_bf16(v1[2], v1[3]);
                    *(u32x4*)(rowp + bj * HALF) = w; } }
    }
};
struct EpiResF32 {
    static constexpr bool PERM = false, AFTER_DRAIN = false;
    const float* res0; const float* res1; int rows0; float* out; int ldc;
    __device__ __forceinline__ void operator()(const f32x4 (&acc)[2][2][4][2], const Unit& u, int wr, int wc, int fr, int fq) const {
        const int col0 = u.pn * BM + wc * 32 + 4 * fq;
#pragma unroll
        for (int ai = 0; ai < 2; ++ai)
#pragma unroll
            for (int m = 0; m < 4; ++m) { const int row = u.pm * BM + ai * HALF + wr * 64 + m * 16 + fr;
                const float* rp = (row < rows0 ? res0 + (size_t)row * ldc : res1 + (size_t)(row - rows0) * ldc) + col0;
                float* op = out + (size_t)row * ldc + col0;
#pragma unroll
                for (int bj = 0; bj < 2; ++bj)
#pragma unroll
                    for (int n = 0; n < 2; ++n) { const f32x4 r = *(const f32x4*)(rp + bj * HALF + n * 16); *(f32x4*)(op + bj * HALF + n * 16) = acc[ai][bj][m][n] + r; } }
    }
};
template <class Epi, class Sched, bool ALIGN_EPI = false, bool SP2 = false>
__device__ __forceinline__ void gemm_phase(PG8_LAS unsigned char* lds, const Gemm g, const Sched& S, const Epi& E) {
    const int tid = threadIdx.x, wid = __builtin_amdgcn_readfirstlane(tid >> 6), lane = tid & 63, wr = wid >> 2, wc = wid & 3, fr = lane & 15, fq = lane >> 4;
    const int K = g.K, nt = K / BK;
    unsigned voffA[2], voffB[2];
#pragma unroll
    for (int i = 0; i < 2; ++i) { int R, C; stage_rc(tid * 16 + i * 8192, R, C); const int Rb = Epi::PERM ? ((R & ~31) + perm32(R & 31)) : R;
        voffA[i] = (unsigned)(R * K + C) * 2u; voffB[i] = (unsigned)(Rb * K + C) * 2u; }
    const size_t kstep = (size_t)(BK * 2);
    const size_t hstep = (size_t)HALF * K * 2;
    const size_t tstep = 2 * hstep;
    const unsigned ldsw = (unsigned)wid * 1024u;
    const int aoff = lds_byte(wr * 64 + fr, fq * 8), boff = lds_byte(wc * 32 + fr, fq * 8);
#define PG8_SA(b, h) (((b) * 2 + (h)) * HTB)
#define PG8_SB(b, h) ((4 + (b) * 2 + (h)) * HTB)
#define PG8_STAGE(bufoff, gbase, voff) do { _Pragma("unroll") for (int _i = 0; _i < 2; ++_i) \
        __builtin_amdgcn_global_load_lds((const unsigned*)((const char*)(gbase) + (voff)[_i]), (PG8_LAS unsigned*)(lds + (bufoff) + ldsw + _i * 8192), 16, 0, 0); } while (0)
#define PG8_LDA(dst, b, h) do { _Pragma("unroll") for (int m = 0; m < 4; ++m) _Pragma("unroll") for (int k = 0; k < 2; ++k) dst[m][k] = *(const PG8_LAS bf16x8*)(lds + PG8_SA(b, h) + aoff + m * 2048 + k * 1024); } while (0)
#define PG8_LDB(dst, b, h) do { _Pragma("unroll") for (int n = 0; n < 2; ++n) _Pragma("unroll") for (int k = 0; k < 2; ++k) dst[n][k] = *(const PG8_LAS bf16x8*)(lds + PG8_SB(b, h) + boff + n * 2048 + k * 1024); } while (0)
#define PG8_MMA(ai, bj, At, Bt) do { __builtin_amdgcn_s_setprio(1); _Pragma("unroll") for (int m = 0; m < 4; ++m) _Pragma("unroll") for (int n = 0; n < 2; ++n) _Pragma("unroll") for (int k = 0; k < 2; ++k) \
        acc[ai][bj][m][n] = __builtin_amdgcn_mfma_f32_16x16x32_bf16(Bt[n][k], At[m][k], acc[ai][bj][m][n], 0, 0, 0); __builtin_amdgcn_s_setprio(0); } while (0)
#define PG8_WAIT_V(n) asm volatile("s_waitcnt vmcnt(" #n ")" ::: "memory")
#define PG8_WAIT_L(n) asm volatile("s_waitcnt lgkmcnt(" #n ")" ::: "memory")
#define PG8_BAR __builtin_amdgcn_s_barrier()
#define PG8_SCHED __builtin_amdgcn_sched_barrier(0)
    Unit cur, nxt; int ui = 0;
    if (!S.next(0, cur)) return;
    f32x4 acc[2][2][4][2];
#pragma unroll
    for (int a = 0; a < 2; ++a)
#pragma unroll
        for (int b = 0; b < 2; ++b)
#pragma unroll
            for (int m = 0; m < 4; ++m)
#pragma unroll
                for (int n = 0; n < 2; ++n) acc[a][b][m][n] = (f32x4){0.f, 0.f, 0.f, 0.f};
    bf16x8 At[4][2], B0[2][2], B1[2][2];
    const char* cA = (const char*)g.A + (size_t)cur.pm * tstep; const char* cB = (const char*)g.Bt + (size_t)cur.pn * tstep;
    S.a_ready(cur);
    if constexpr (SP2) {
        PG8_STAGE(PG8_SB(0, 0), cB, voffB); PG8_STAGE(PG8_SB(0, 1), cB + hstep, voffB); PG8_STAGE(PG8_SA(0, 0), cA, voffA); PG8_STAGE(PG8_SA(0, 1), cA + hstep, voffA);
        if (wr == 1) PG8_BAR;
        PG8_WAIT_V(2); PG8_BAR;
        PG8_STAGE(PG8_SB(1, 0), cB + kstep, voffB); PG8_STAGE(PG8_SA(1, 0), cA + kstep, voffA); PG8_STAGE(PG8_SB(1, 1), cB + hstep + kstep, voffB);
        PG8_WAIT_V(6); PG8_BAR;
    } else {
        PG8_STAGE(PG8_SB(0, 0), cB, voffB); PG8_STAGE(PG8_SA(0, 0), cA, voffA); PG8_STAGE(PG8_SB(0, 1), cB + hstep, voffB); PG8_STAGE(PG8_SA(0, 1), cA + hstep, voffA);
        if (wr == 1) PG8_BAR;
        PG8_WAIT_V(4); PG8_BAR;
        PG8_STAGE(PG8_SB(1, 0), cB + kstep, voffB); PG8_STAGE(PG8_SA(1, 0), cA + kstep, voffA); PG8_STAGE(PG8_SB(1, 1), cB + hstep + kstep, voffB);
        PG8_WAIT_V(6); PG8_BAR;
    }
    for (;;) {
        const bool has_next = S.next(ui + 1, nxt);
        const char* nA = has_next ? (const char*)g.A + (size_t)nxt.pm * tstep : cA; const char* nB = has_next ? (const char*)g.Bt + (size_t)nxt.pn * tstep : cB;
        for (int t = 0; t < nt; t += 2) {
            const bool last = (t == nt - 2);
            const char* a1 = cA + (size_t)(t + 1) * kstep;
            const char* a2 = last ? nA : cA + (size_t)(t + 2) * kstep; const char* b2 = last ? nB : cB + (size_t)(t + 2) * kstep;
            const char* a3 = a2 + kstep; const char* b3 = b2 + kstep;
            if (last && has_next) S.a_ready(nxt);
            if constexpr (SP2) {
            PG8_LDB(B0, 0, 0); PG8_LDB(B1, 0, 1); PG8_SCHED; PG8_LDA(At, 0, 0); PG8_STAGE(PG8_SA(1, 1), a1 + hstep, voffA);
            PG8_WAIT_V(8); PG8_WAIT_L(0); PG8_BAR; PG8_MMA(0, 0, At, B0); PG8_MMA(0, 1, At, B1); PG8_BAR; PG8_SCHED;
            PG8_LDA(At, 0, 1); PG8_STAGE(PG8_SB(0, 0), b2, voffB); PG8_STAGE(PG8_SB(0, 1), b2 + hstep, voffB); PG8_STAGE(PG8_SA(0, 0), a2, voffA);
            PG8_WAIT_V(8); PG8_WAIT_L(0); PG8_BAR; PG8_MMA(1, 0, At, B0); PG8_MMA(1, 1, At, B1); PG8_BAR; PG8_SCHED;
            PG8_LDB(B0, 1, 0); PG8_LDB(B1, 1, 1); PG8_SCHED; PG8_LDA(At, 1, 0); PG8_STAGE(PG8_SA(0, 1), a2 + hstep, voffA);
            PG8_WAIT_V(8); PG8_WAIT_L(0); PG8_BAR; PG8_MMA(0, 0, At, B0); PG8_MMA(0, 1, At, B1); PG8_BAR; PG8_SCHED;
            PG8_LDA(At, 1, 1); PG8_STAGE(PG8_SB(1, 0), b3, voffB); PG8_STAGE(PG8_SB(1, 1), b3 + hstep, voffB); PG8_STAGE(PG8_SA(1, 0), a3, voffA);
            PG8_WAIT_V(8); PG8_WAIT_L(0); PG8_BAR; PG8_MMA(1, 0, At, B0); PG8_MMA(1, 1, At, B1); PG8_BAR; PG8_SCHED;
            } else {
            PG8_LDB(B0, 0, 0); PG8_SCHED; PG8_LDA(At, 0, 0); PG8_STAGE(PG8_SA(1, 1), a1 + hstep, voffA);
            PG8_WAIT_L(8); PG8_BAR; PG8_WAIT_L(0); PG8_MMA(0, 0, At, B0); PG8_BAR; PG8_SCHED;
            PG8_LDB(B1, 0, 1); PG8_STAGE(PG8_SB(0, 0), b2, voffB);
            PG8_BAR; PG8_WAIT_L(0); PG8_MMA(0, 1, At, B1); PG8_BAR;
            PG8_LDA(At, 0, 1); PG8_STAGE(PG8_SA(0, 0), a2, voffA);
            PG8_BAR; PG8_WAIT_L(0); PG8_MMA(1, 0, At, B0); PG8_BAR; PG8_SCHED;
            PG8_STAGE(PG8_SB(0, 1), b2 + hstep, voffB);
            PG8_WAIT_V(6); PG8_BAR; PG8_MMA(1, 1, At, B1); PG8_BAR;
            PG8_LDB(B0, 1, 0); PG8_SCHED; PG8_LDA(At, 1, 0); PG8_STAGE(PG8_SA(0, 1), a2 + hstep, voffA);
            PG8_WAIT_L(8); PG8_BAR; PG8_WAIT_L(0); PG8_MMA(0, 0, At, B0); PG8_BAR; PG8_SCHED;
            PG8_LDB(B1, 1, 1); PG8_STAGE(PG8_SB(1, 0), b3, voffB);
            PG8_BAR; PG8_WAIT_L(0); PG8_MMA(0, 1, At, B1); PG8_BAR;
            PG8_LDA(At, 1, 1); PG8_STAGE(PG8_SA(1, 0), a3, voffA);
            PG8_BAR; PG8_WAIT_L(0); PG8_MMA(1, 0, At, B0); PG8_BAR; PG8_SCHED;
            PG8_STAGE(PG8_SB(1, 1), b3 + hstep, voffB);
            PG8_WAIT_V(6); PG8_BAR; PG8_MMA(1, 1, At, B1); PG8_BAR;
            }
        }
        if constexpr (ALIGN_EPI) { if (wr == 0) PG8_BAR; }
        if constexpr (!Epi::AFTER_DRAIN) { E(acc, cur, wr, wc, fr, fq); S.done(cur); }
        if (!has_next) break;
#pragma unroll
        for (int a = 0; a < 2; ++a)
#pragma unroll
            for (int b = 0; b < 2; ++b)
#pragma unroll
                for (int m = 0; m < 4; ++m)
#pragma unroll
                    for (int n = 0; n < 2; ++n) acc[a][b][m][n] = (f32x4){0.f, 0.f, 0.f, 0.f};
        cur = nxt; cA = nA; cB = nB; ++ui;
        if constexpr (ALIGN_EPI) { if (wr == 1) PG8_BAR; }
    }
    PG8_WAIT_V(0);
    if constexpr (!ALIGN_EPI) { if (wr == 0) PG8_BAR; }
    PG8_BAR;
    if constexpr (Epi::AFTER_DRAIN) { E.fused(acc, cur, wr, wc, fr, fq, lds, wid, lane); S.done(cur); }
#undef PG8_SA
#undef PG8_SB
#undef PG8_STAGE
#undef PG8_LDA
#undef PG8_LDB
#undef PG8_MMA
#undef PG8_WAIT_V
#undef PG8_WAIT_L
#undef PG8_BAR
#undef PG8_SCHED
}
}
#define GAS __attribute__((address_space(1)))
#define LAS __attribute__((address_space(3)))
typedef unsigned short bf16;
typedef unsigned v4u __attribute__((ext_vector_type(4)));
typedef float f32x4 __attribute__((ext_vector_type(4)));
typedef short bf16x8 __attribute__((ext_vector_type(8)));
typedef GAS unsigned gu32;
typedef GAS unsigned long long gu64;
#define RLX_AGENT __ATOMIC_RELAXED, __HIP_MEMORY_SCOPE_AGENT
#define LDS_WAIT() asm volatile("s_waitcnt lgkmcnt(0)" ::: "memory")
#define VM_WAIT() asm volatile("s_waitcnt vmcnt(0)" ::: "memory")
__device__ __forceinline__ unsigned long long rt() { return __builtin_amdgcn_s_memrealtime(); }
__device__ __forceinline__ unsigned f2bf(float f) { unsigned u = __builtin_bit_cast(unsigned, f); return (u + 0x7fffu + ((u >> 16) & 1u)) >> 16; }
__device__ __forceinline__ unsigned pk2(float lo, float hi) { return f2bf(lo) | (f2bf(hi) << 16); }

#define XB_TMO      128
#define XB_XCNT(j)  (256  + 64 * (j))
#define XB_XSUB(j)  (1280 + 64 * (j))
#define XB_XGEN(j)  (2304 + 64 * (j))
#define XB_TOP      3328
#define XB_TOPGEN   3392
#define XCD_BAR_WORDS 3456
#define XB_SPIN_CAP (1u << 18)

__device__ __forceinline__ unsigned xb_ld(unsigned* p)              { return __hip_atomic_load(p, __ATOMIC_RELAXED, __HIP_MEMORY_SCOPE_AGENT); }
__device__ __forceinline__ unsigned xb_add(unsigned* p, unsigned v) { return __hip_atomic_fetch_add(p, v, __ATOMIC_RELAXED, __HIP_MEMORY_SCOPE_AGENT); }
__device__ __forceinline__ unsigned xb_xcc_id() { return (unsigned)__builtin_amdgcn_s_getreg((3 << 11) | 20) & 0xFu; }
#define XB_SPIN(cond, bar) do { unsigned _sp = 0; while (cond) { __builtin_amdgcn_s_sleep(1); \
    if ((++_sp & 255u) == 0u) { if (xb_ld(&(bar)[XB_TMO])) break; if (_sp > XB_SPIN_CAP) { atomicAdd(&(bar)[XB_TMO], 1u); break; } } } } while (0)

struct XcdBarrier {
    unsigned* bar; unsigned x;
    volatile LAS unsigned* st;
};

__device__ __forceinline__ XcdBarrier xcd_barrier_post(unsigned* bar, volatile LAS unsigned* st) {
    XcdBarrier b; b.bar = bar; b.x = xb_xcc_id(); b.st = st;
    if (threadIdx.x == 0) (void)xb_add(&bar[XB_XCNT(b.x)], 1u);
    return b;
}
__device__ __forceinline__ void xcd_barrier_complete(unsigned* bar, unsigned x, unsigned& nloc, unsigned& nx) {
    const unsigned G = gridDim.x * gridDim.y * gridDim.z;
    unsigned sum, cnt, mine, sp = 0u;
    for (;;) {
        sum = 0u; cnt = 0u; mine = 0u;
#pragma unroll
        for (unsigned j = 0; j < 16; ++j) { const unsigned c = xb_ld(&bar[XB_XCNT(j)]); sum += c; cnt += (c > 0u) ? 1u : 0u; mine = (j == x) ? c : mine; }
        if (sum == G) break;
        __builtin_amdgcn_s_sleep(1);
        if ((++sp & 255u) == 0u) { if (xb_ld(&bar[XB_TMO])) break; if (sp > XB_SPIN_CAP) { atomicAdd(&bar[XB_TMO], 1u); break; } }
    }
    nloc = mine > 0u ? mine : 1u; nx = cnt > 0u ? cnt : 1u;
}

__device__ __forceinline__ void xcd_barrier(const XcdBarrier& b) {
    asm volatile("s_waitcnt vmcnt(0)" ::: "memory");
    __syncthreads();
    if (threadIdx.x == 0) {
        unsigned* bar = b.bar;
        __builtin_amdgcn_s_waitcnt(0);
        unsigned nloc = b.st[0], nx = b.st[1];
        if (nloc == 0u) { xcd_barrier_complete(bar, b.x, nloc, nx); b.st[0] = nloc; b.st[1] = nx; }
        const unsigned old = xb_add(&bar[XB_XSUB(b.x)], 1u);
        const unsigned gen = old / nloc;
        if (old + 1u == (gen + 1u) * nloc) {
            __builtin_amdgcn_fence(__ATOMIC_RELEASE, "agent");
            asm volatile("s_waitcnt vmcnt(0)" ::: "memory");
            const unsigned og = xb_add(&bar[XB_TOP], 1u);
            const unsigned tg = og / nx;
            if (og + 1u == (tg + 1u) * nx) xb_add(&bar[XB_TOPGEN], 1u);
            else XB_SPIN(xb_ld(&bar[XB_TOPGEN]) == tg, bar);
            __builtin_amdgcn_fence(__ATOMIC_ACQUIRE, "agent");
            xb_add(&bar[XB_XGEN(b.x)], 1u);
            asm volatile("s_waitcnt vmcnt(0)" ::: "memory");
        } else {
            XB_SPIN(xb_ld(&bar[XB_XGEN(b.x)]) == gen, bar);
            __builtin_amdgcn_fence(__ATOMIC_ACQUIRE, "agent");
            asm volatile("s_waitcnt vmcnt(0)" ::: "memory");
        }
    }
    __syncthreads();
}

constexpr int DM = 1024, SEQ = 8192, PB = 4, SB = 128, ST = 4, LBUF = 2048;
constexpr int NP = PB * SEQ;
constexpr int NS = SB * ST;
constexpr int MT = NP + NS;
constexpr int DIN = 4104, NPROJ = 4096;
constexpr int CONVCH = 1536;
constexpr int PC_ZA = 1536, PC_QB = 2048, PC_KB = 2560, PC_VB = 3072, PC_ZB = 3584;
constexpr float NORM_EPS = 1e-6f;
constexpr size_t O_YP = 0, O_YS = (size_t)NP * DM, O_CONVP = O_YS + (size_t)NS * DM, O_DELTAP = O_CONVP + (size_t)PB * 3 * CONVCH,
                 O_KWP = O_DELTAP + (size_t)PB * 4 * 128 * 128, O_VWP = O_KWP + (size_t)PB * LBUF * 512, O_CONVS = O_VWP + (size_t)PB * LBUF * 512,
                 O_DELTAS = O_CONVS + (size_t)SB * 3 * CONVCH, O_KWS = O_DELTAS + (size_t)SB * 4 * 128 * 128, O_VWS = O_KWS + (size_t)SB * LBUF * 512,
                 O_END = O_VWS + (size_t)SB * LBUF * 512;
constexpr size_t MiB = 1u << 20;
constexpr size_t WS_CTL = 0, CTL_ZERO_BYTES = 1 * MiB;
constexpr size_t WS_WIN = 2 * MiB, WS_WOUT = 10 * MiB, WS_GB = 12 * MiB, WS_XN = 16 * MiB, WS_PROJ = 96 * MiB, WS_OA = 360 * MiB, WS_MIX = 432 * MiB, WS_CHK = 512 * MiB, WS_UT = 624 * MiB, WS_GL = 656 * MiB, WS_END = 657 * MiB;
constexpr int CW_TMO = 0, CW_BAR = 4096;
constexpr int LDS_BYTES = 147456, MISC_OFF = LDS_BYTES - 256;
constexpr int NWAVES = 8, NTHR = 512;

struct Args { const float* in[14]; float* out; unsigned char* ws; int ph_lo, ph_hi; };
enum { I_XP = 0, I_XS, I_SCONV, I_SDELTA, I_CK, I_CV, I_NORMG, I_FNORMG, I_WIN, I_CONVW, I_ALOG, I_DTB, I_DNG, I_WOUT };

struct Frame {
    LAS unsigned char* lds;
    int tid, lane, wave, G;
    const float* in[14]; float* out; unsigned char* ws;
    bf16 *WinT, *WoutT, *XN, *PROJ, *MIX; float *GB, *OA;
};

__device__ __forceinline__ float wave_sum(float v) {
#pragma unroll
    for (int o = 1; o < 64; o <<= 1) v += __shfl_xor(v, o);
    return v;
}
__device__ __forceinline__ float bf2f(bf16 v) { return __uint_as_float((unsigned)v << 16); }
__device__ __forceinline__ float bflo(unsigned w) { return __uint_as_float(w << 16); }
__device__ __forceinline__ float bfhi(unsigned w) { return __uint_as_float(w & 0xffff0000u); }
__device__ __forceinline__ float siluf(float y) { return y / (1.f + __expf(-y)); }

__device__ __forceinline__ void p0_transpose_item(const float* W, int K, int ldw, int c0, bf16* WT, int n0, int k0, LAS float* scr, int lane) {
#pragma unroll 8
    for (int i = 0; i < 32; ++i) { const int kk = 2 * i + (lane >> 5); scr[kk * 33 + (lane & 31)] = W[(size_t)(k0 + kk) * ldw + c0 + (lane & 31)]; }
    LDS_WAIT(); asm volatile("" ::: "memory");
    const int c = lane & 7;
#pragma unroll
    for (int j = 0; j < 4; ++j) { const int n = (lane >> 3) + 8 * j; const LAS float* s = scr + (8 * c) * 33 + n;
        v4u o; o.x = pk2(s[0 * 33], s[1 * 33]); o.y = pk2(s[2 * 33], s[3 * 33]); o.z = pk2(s[4 * 33], s[5 * 33]); o.w = pk2(s[6 * 33], s[7 * 33]);
        *(GAS v4u*)(WT + (size_t)(n0 + n) * K + k0 + 8 * c) = o; }
    LDS_WAIT(); asm volatile("" ::: "memory");
}
__device__ __forceinline__ void p0_prologue(Frame& F) {
    LAS float* W8T = (LAS float*)(F.lds);
    const float* w_in = F.in[I_WIN];
    for (int i = F.tid; i < 8 * 1024; i += NTHR) { const int k = i >> 3, e = i & 7; W8T[e * 1024 + k] = w_in[(size_t)k * DIN + 2048 + e]; }
    __syncthreads();
    const int gw = blockIdx.x * NWAVES + F.wave, NGW = F.G * NWAVES;
    const float* ng = F.in[I_NORMG];
    f32x4 gv[4];
#pragma unroll
    for (int j = 0; j < 4; ++j) gv[j] = *(const f32x4*)(ng + 4 * F.lane + 256 * j);
    const float a_log_l = (F.lane < 4) ? F.in[I_ALOG][F.lane] : 0.f, dtb_l = (F.lane < 4) ? F.in[I_DTB][F.lane] : 0.f;
    for (int m = gw; m < MT; m += NGW) {
        const float* xrow = (m < NP) ? F.in[I_XP] + (size_t)m * DM : F.in[I_XS] + (size_t)(m - NP) * DM;
        const GAS f32x4* xr = (const GAS f32x4*)xrow + F.lane;
        f32x4 v[4]; float s = 0.f;
#pragma unroll
        for (int j = 0; j < 4; ++j) { v[j] = xr[64 * j]; s += (v[j].x * v[j].x + v[j].y * v[j].y) + (v[j].z * v[j].z + v[j].w * v[j].w); }
        const float rs = 1.f / sqrtf(wave_sum(s) * (1.f / DM) + NORM_EPS);
#pragma unroll
        for (int j = 0; j < 4; ++j) v[j] = v[j] * rs * gv[j];
        GAS unsigned long long* o8 = (GAS unsigned long long*)(F.XN + (size_t)m * DM) + F.lane;
#pragma unroll
        for (int j = 0; j < 4; ++j) o8[64 * j] = (unsigned long long)pk2(v[j].x, v[j].y) | ((unsigned long long)pk2(v[j].z, v[j].w) << 32);
        float d[8];
#pragma unroll
        for (int e = 0; e < 8; ++e) { float acc = 0.f;
#pragma unroll
            for (int j = 0; j < 4; ++j) { const f32x4 w = *(const LAS f32x4*)(W8T + e * 1024 + 4 * F.lane + 256 * j); acc += (v[j].x * w.x + v[j].y * w.y) + (v[j].z * w.z + v[j].w * w.w); }
            d[e] = wave_sum(acc); }
        float mine = 0.f;
#pragma unroll
        for (int e = 0; e < 8; ++e) mine = (F.lane == e) ? d[e] : mine;
        if (F.lane < 4) { const float xx = mine + dtb_l; const float sp = xx > 20.f ? xx : log1pf(expf(xx)); F.GB[(size_t)m * 8 + F.lane] = -expf(a_log_l) * sp; }
        else if (F.lane < 8) { F.GB[(size_t)m * 8 + F.lane] = 1.f / (1.f + expf(-mine)); }
    }
    __syncthreads();
    LAS float* scr = (LAS float*)(F.lds + 32768 + F.wave * 8448);
    constexpr int I_IN = (DM / 64) * (NPROJ / 32), I_OUT = (DM / 64) * (DM / 32);
    for (int it = gw; it < I_IN + I_OUT; it += NGW) {
        if (it < I_IN) { const int kb = it / (NPROJ / 32), nb = it % (NPROJ / 32), n0 = nb * 32; p0_transpose_item(w_in, DM, DIN, n0 + (n0 >= 2048 ? 8 : 0), F.WinT, n0, kb * 64, scr, F.lane); }
        else { const int r = it - I_IN, kb = r / (DM / 32), nb = r % (DM / 32); p0_transpose_item(F.in[I_WOUT], DM, DM, nb * 32, F.WoutT, nb * 32, kb * 64, scr, F.lane); }
    }
}

__device__ __forceinline__ void dn_seq_unit(Frame& F, int unit) {
    LAS float* cv = (LAS float*)F.lds;
    LAS float* part = cv + 384;
    LAS float* psum = cv + 512;
    LAS float* osum = cv + 1024;
    const int t = F.tid, dv = t & 127, qd = t >> 7;
    int L, row0, h; const float* prefix; const float* S0; float* Sout;
    if (unit < 16) { const int b = unit >> 2; h = unit & 3; L = SEQ; row0 = b * SEQ; prefix = nullptr; S0 = nullptr; Sout = F.out + O_DELTAP + (size_t)unit * 16384; }
    else { const int u = unit - 16, b = u >> 2; h = u & 3; L = ST; row0 = NP + b * ST; prefix = F.in[I_SCONV] + (size_t)b * 3 * CONVCH; S0 = F.in[I_SDELTA] + (size_t)u * 16384; Sout = F.out + O_DELTAS + (size_t)u * 16384; }
    float S[32];
#pragma unroll
    for (int i = 0; i < 32; ++i) S[i] = S0 ? S0[(size_t)(qd * 32 + i) * 128 + dv] : 0.f;
    const int which = t >> 7, ch = t & 127, gcol = (which < 3 ? which : 0) * 512 + h * 128 + ch;
    float w0 = 0.f, w1 = 0.f, w2 = 0.f, w3 = 0.f, x0 = 0.f, x1 = 0.f, x2 = 0.f;
    if (t < 384) { const float* cw = F.in[I_CONVW]; w0 = cw[gcol]; w1 = cw[CONVCH + gcol]; w2 = cw[2 * CONVCH + gcol]; w3 = cw[3 * CONVCH + gcol];
        if (prefix) { x0 = prefix[gcol]; x1 = prefix[CONVCH + gcol]; x2 = prefix[2 * CONVCH + gcol]; } }
    __syncthreads();
    for (int tau = 0; tau < L; ++tau) {
        const size_t row = (size_t)(row0 + tau);
        float ss = 0.f;
        if (t < 384) { const float x3 = bf2f(F.PROJ[row * NPROJ + gcol]); float y = w0 * x0 + w1 * x1 + w2 * x2 + w3 * x3; x0 = x1; x1 = x2; x2 = x3; y = siluf(y); cv[t] = y; ss = (t < 256) ? y * y : 0.f; }
        if (F.wave < 4) { ss = wave_sum(ss); if (F.lane == 0) part[F.wave] = ss; }
        __syncthreads();
        const float qn = (1.f / sqrtf(part[0] + part[1] + NORM_EPS)) * 0.08838834764831845f, kn = 1.f / sqrtf(part[2] + part[3] + NORM_EPS);
        const float g = F.GB[row * 8 + h], beta = F.GB[row * 8 + 4 + h], a = expf(g);
        float p = 0.f;
#pragma unroll
        for (int i = 0; i < 32; ++i) { S[i] *= a; p += S[i] * cv[128 + qd * 32 + i]; }
        psum[qd * 128 + dv] = p * kn;
        __syncthreads();
        const float ptot = (psum[dv] + psum[128 + dv]) + (psum[256 + dv] + psum[384 + dv]);
        const float r = beta * (cv[256 + dv] - ptot);
        float o = 0.f;
#pragma unroll
        for (int i = 0; i < 32; ++i) { S[i] += (cv[128 + qd * 32 + i] * kn) * r; o += S[i] * cv[qd * 32 + i]; }
        osum[qd * 128 + dv] = o * qn;
        __syncthreads();
        if (qd == 0) F.OA[row * 512 + h * 128 + dv] = (osum[dv] + osum[128 + dv]) + (osum[256 + dv] + osum[384 + dv]);
    }
#pragma unroll
    for (int i = 0; i < 32; ++i) Sout[(size_t)(qd * 32 + i) * 128 + dv] = S[i];
    __syncthreads();
}

__device__ __forceinline__ void ld_bf16x64(const bf16* p, float (&v)[64]) {
    const v4u* p4 = (const v4u*)p;
#pragma unroll
    for (int i = 0; i < 8; ++i) { const v4u w = p4[i]; v[8 * i] = bflo(w.x); v[8 * i + 1] = bfhi(w.x); v[8 * i + 2] = bflo(w.y); v[8 * i + 3] = bfhi(w.y); v[8 * i + 4] = bflo(w.z); v[8 * i + 5] = bfhi(w.z); v[8 * i + 6] = bflo(w.w); v[8 * i + 7] = bfhi(w.w); }
}
__device__ __forceinline__ float dot_bf16row(const bf16* p, const float (&q)[64]) {
    const v4u* p4 = (const v4u*)p; float s = 0.f;
#pragma unroll
    for (int i = 0; i < 8; ++i) { const v4u w = p4[i]; s += q[8 * i] * bflo(w.x) + q[8 * i + 1] * bfhi(w.x) + q[8 * i + 2] * bflo(w.y) + q[8 * i + 3] * bfhi(w.y) + q[8 * i + 4] * bflo(w.z) + q[8 * i + 5] * bfhi(w.z) + q[8 * i + 6] * bflo(w.w) + q[8 * i + 7] * bfhi(w.w); }
    return s;
}
__device__ __forceinline__ void axpy_bf16row(const bf16* p, float a, float sc, float (&o)[64]) {
    const v4u* p4 = (const v4u*)p;
#pragma unroll
    for (int i = 0; i < 8; ++i) { const v4u w = p4[i];
        o[8 * i] = o[8 * i] * sc + a * bflo(w.x); o[8 * i + 1] = o[8 * i + 1] * sc + a * bfhi(w.x); o[8 * i + 2] = o[8 * i + 2] * sc + a * bflo(w.y); o[8 * i + 3] = o[8 * i + 3] * sc + a * bfhi(w.y);
        o[8 * i + 4] = o[8 * i + 4] * sc + a * bflo(w.z); o[8 * i + 5] = o[8 * i + 5] * sc + a * bfhi(w.z); o[8 * i + 6] = o[8 * i + 6] * sc + a * bflo(w.w); o[8 * i + 7] = o[8 * i + 7] * sc + a * bfhi(w.w); }
}
__device__ __forceinline__ float dot_f32row(const float* p, const float (&q)[64]) {
    const f32x4* p4 = (const f32x4*)p; float s = 0.f;
#pragma unroll
    for (int i = 0; i < 16; ++i) { const f32x4 w = p4[i]; s += q[4 * i] * w.x + q[4 * i + 1] * w.y + q[4 * i + 2] * w.z + q[4 * i + 3] * w.w; }
    return s;
}
__device__ __forceinline__ void axpy_f32row(const float* p, float a, float sc, float (&o)[64]) {
    const f32x4* p4 = (const f32x4*)p;
#pragma unroll
    for (int i = 0; i < 16; ++i) { const f32x4 w = p4[i]; o[4 * i] = o[4 * i] * sc + a * w.x; o[4 * i + 1] = o[4 * i + 1] * sc + a * w.y; o[4 * i + 2] = o[4 * i + 2] * sc + a * w.z; o[4 * i + 3] = o[4 * i + 3] * sc + a * w.w; }
}
__device__ __forceinline__ void attn_write(Frame& F, size_t row, int h, const float (&o)[64], float l) {
    float z[64]; ld_bf16x64(F.PROJ + row * NPROJ + PC_ZB + h * 64, z);
    const float il = 1.f / l;
    v4u* dst = (v4u*)(F.MIX + row * DM + 512 + h * 64);
#pragma unroll
    for (int i = 0; i < 8; ++i) { v4u w; w.x = pk2(o[8 * i] * il * siluf(z[8 * i]), o[8 * i + 1] * il * siluf(z[8 * i + 1])); w.y = pk2(o[8 * i + 2] * il * siluf(z[8 * i + 2]), o[8 * i + 3] * il * siluf(z[8 * i + 3]));
        w.z = pk2(o[8 * i + 4] * il * siluf(z[8 * i + 4]), o[8 * i + 5] * il * siluf(z[8 * i + 5])); w.w = pk2(o[8 * i + 6] * il * siluf(z[8 * i + 6]), o[8 * i + 7] * il * siluf(z[8 * i + 7])); dst[i] = w; }
}
__device__ __forceinline__ void attn_simple(Frame& F) {
    const int gt = blockIdx.x * NTHR + F.tid, NGT = F.G * NTHR;
    for (int it = gt; it < PB * 8 * SEQ; it += NGT) {
        const int bh = it >> 13, pos = it & (SEQ - 1), b = bh >> 3, h = bh & 7; const size_t row = (size_t)b * SEQ + pos;
        float q[64]; ld_bf16x64(F.PROJ + row * NPROJ + PC_QB + h * 64, q);
#pragma unroll
        for (int i = 0; i < 64; ++i) q[i] *= 0.125f;
        float o[64];
#pragma unroll
        for (int i = 0; i < 64; ++i) o[i] = 0.f;
        float m = -INFINITY, l = 0.f;
        for (int br = 0; br < 3; ++br) { const int d = br == 0 ? 1 : (br == 1 ? 4 : 16);
            for (int j = 0; j <= 128; ++j) { const int kp = pos - d * j; if (kp < 0) break;
                const bf16* kr = F.PROJ + ((size_t)b * SEQ + kp) * NPROJ + h * 64;
                const float s = dot_bf16row(kr + PC_KB, q); const float mn = fmaxf(m, s), sc = __expf(m - mn), p = __expf(s - mn);
                l = l * sc + p; axpy_bf16row(kr + PC_VB, p, sc, o); m = mn; } }
        attn_write(F, row, h, o, l);
    }
    for (int it = gt; it < SB * 8 * ST; it += NGT) {
        const int t = it & 3, bh = it >> 2, b = bh >> 3, h = bh & 7; const size_t row = (size_t)NP + b * ST + t;
        float q[64]; ld_bf16x64(F.PROJ + row * NPROJ + PC_QB + h * 64, q);
#pragma unroll
        for (int i = 0; i < 64; ++i) q[i] *= 0.125f;
        float o[64];
#pragma unroll
        for (int i = 0; i < 64; ++i) o[i] = 0.f;
        float m = -INFINITY, l = 0.f;
        for (int br = 0; br < 3; ++br) { const int d = br == 0 ? 1 : (br == 1 ? 4 : 16);
            for (int j = 0; j <= 128; ++j) { const int idx = LBUF + t - d * j; if (idx < 0) break;
                float s;
                if (idx >= LBUF) { const bf16* kr = F.PROJ + ((size_t)NP + b * ST + (idx - LBUF)) * NPROJ + h * 64; s = dot_bf16row(kr + PC_KB, q);
                    const float mn = fmaxf(m, s), sc = __expf(m - mn), p = __expf(s - mn); l = l * sc + p; axpy_bf16row(kr + PC_VB, p, sc, o); m = mn; }
                else { const size_t off = ((size_t)b * LBUF + idx) * 512 + h * 64; s = dot_f32row(F.in[I_CK] + off, q);
                    const float mn = fmaxf(m, s), sc = __expf(m - mn), p = __expf(s - mn); l = l * sc + p; axpy_f32row(F.in[I_CV] + off, p, sc, o); m = mn; } } }
        attn_write(F, row, h, o, l);
    }
}

__device__ __forceinline__ f32x4 ld4bf(const bf16* p) { const unsigned long long w = *(const unsigned long long*)p; return (f32x4){bflo((unsigned)w), bfhi((unsigned)w), bflo((unsigned)(w >> 32)), bfhi((unsigned)(w >> 32))}; }
__device__ __forceinline__ void copy_outputs(Frame& F) {
    const size_t gt = (size_t)blockIdx.x * NTHR + F.tid, NGT = (size_t)F.G * NTHR;
    for (size_t i = gt; i < ((size_t)2 << 25); i += NGT) {
        const int which = (int)(i >> 25); const size_t rem = i & (((size_t)1 << 25) - 1); const int b = (int)(rem >> 18), w = (int)(rem & ((1 << 18) - 1)), r = w >> 7, c4 = w & 127;
        f32x4 v;
        if (r < LBUF - ST) v = *(const f32x4*)(F.in[which ? I_CV : I_CK] + ((size_t)b * LBUF + r + ST) * 512 + c4 * 4);
        else v = ld4bf(F.PROJ + ((size_t)NP + b * ST + (r - (LBUF - ST))) * NPROJ + (which ? PC_VB : PC_KB) + c4 * 4);
        *(f32x4*)(F.out + (which ? O_VWS : O_KWS) + rem * 4) = v;
    }
    for (size_t i = gt; i < ((size_t)2 << 20); i += NGT) {
        const int which = (int)(i >> 20); const size_t rem = i & (((size_t)1 << 20) - 1); const int b = (int)(rem >> 18), w = (int)(rem & ((1 << 18) - 1)), r = w >> 7, c4 = w & 127;
        *(f32x4*)(F.out + (which ? O_VWP : O_KWP) + rem * 4) = ld4bf(F.PROJ + ((size_t)b * SEQ + (SEQ - LBUF) + r) * NPROJ + (which ? PC_VB : PC_KB) + c4 * 4);
    }
    for (size_t i = gt; i < (size_t)(PB + SB) * 3 * (CONVCH / 4); i += NGT) {
        const int c4 = (int)(i % (CONVCH / 4)), rr = (int)(i / (CONVCH / 4)), j = rr % 3, b = rr / 3;
        if (b < PB) *(f32x4*)(F.out + O_CONVP + ((size_t)b * 3 + j) * CONVCH + c4 * 4) = ld4bf(F.PROJ + ((size_t)b * SEQ + SEQ - 3 + j) * NPROJ + c4 * 4);
        else { const int bs = b - PB; *(f32x4*)(F.out + O_CONVS + ((size_t)bs * 3 + j) * CONVCH + c4 * 4) = ld4bf(F.PROJ + ((size_t)NP + bs * ST + 1 + j) * NPROJ + c4 * 4); }
    }
}

__device__ __forceinline__ void mix_a_finish(Frame& F) {
    const int gw = blockIdx.x * NWAVES + F.wave, NGW = F.G * NWAVES;
    const float g0 = F.in[I_DNG][2 * F.lane], g1 = F.in[I_DNG][2 * F.lane + 1];
    for (int it = gw; it < MT * 4; it += NGW) {
        const size_t row = (size_t)(it >> 2); const int h = it & 3;
        const float2 v = *(const float2*)(F.OA + row * 512 + h * 128 + 2 * F.lane);
        const float rs = 1.f / sqrtf(wave_sum(v.x * v.x + v.y * v.y) * (1.f / 128.f) + NORM_EPS);
        const unsigned zw = *(const unsigned*)(F.PROJ + row * NPROJ + PC_ZA + h * 128 + 2 * F.lane);
        *(unsigned*)(F.MIX + row * DM + h * 128 + 2 * F.lane) = pk2(v.x * rs * g0 * siluf(bflo(zw)), v.y * rs * g1 * siluf(bfhi(zw)));
    }
}
__device__ __forceinline__ void final_norm(Frame& F) {
    const int gw = blockIdx.x * NWAVES + F.wave, NGW = F.G * NWAVES;
    f32x4 gv[4];
#pragma unroll
    for (int j = 0; j < 4; ++j) gv[j] = *(const f32x4*)(F.in[I_FNORMG] + 4 * F.lane + 256 * j);
    for (int m = gw; m < MT; m += NGW) {
        GAS f32x4* yr = (GAS f32x4*)(F.out + (size_t)m * DM) + F.lane;
        f32x4 v[4]; float s = 0.f;
#pragma unroll
        for (int j = 0; j < 4; ++j) { v[j] = yr[64 * j]; s += (v[j].x * v[j].x + v[j].y * v[j].y) + (v[j].z * v[j].z + v[j].w * v[j].w); }
        const float rs = 1.f / sqrtf(wave_sum(s) * (1.f / DM) + NORM_EPS);
#pragma unroll
        for (int j = 0; j < 4; ++j) yr[64 * j] = v[j] * rs * gv[j];
    }
}


typedef float f32x16 __attribute__((ext_vector_type(16)));
typedef float f32x2_t __attribute__((ext_vector_type(2)));
typedef __bf16 bf16x2_t __attribute__((ext_vector_type(2)));
typedef unsigned v2u __attribute__((ext_vector_type(2)));
__device__ __forceinline__ unsigned cvtpk(float lo, float hi) { f32x2_t v = {lo, hi}; bf16x2_t b = __builtin_convertvector(v, bf16x2_t); return __builtin_bit_cast(unsigned, b); }
__device__ __forceinline__ int crow(int r, int hi) { return (r & 3) + 8 * (r >> 2) + 4 * hi; }
#define MFMA32(a, b, c) __builtin_amdgcn_mfma_f32_32x32x16_bf16((a), (b), (c), 0, 0, 0)
__device__ __forceinline__ bf16x8 pack8(const f32x16& x, int s) {
    v4u p; p.x = cvtpk(x[8 * s], x[8 * s + 1]); p.y = cvtpk(x[8 * s + 2], x[8 * s + 3]); p.z = cvtpk(x[8 * s + 4], x[8 * s + 5]); p.w = cvtpk(x[8 * s + 6], x[8 * s + 7]);
    return __builtin_bit_cast(bf16x8, p);
}
constexpr int CHK_BYTES = 57344, CHK_WF = 0, CHK_QF = 16384, CHK_AF = 32768, CHK_KF = 40960;
constexpr int NCHUNK = SEQ / 64, NUNIT = PB * 4 * NCHUNK;
constexpr int CP_ROWB = 272;
constexpr int CP_QB = 0, CP_KB = 17408, CP_VB = 34816, CP_AM = 52224, CP_GC = 68608, CP_BETA = 68864, CP_EG = 69120, CP_HALF = 69632;

__device__ __forceinline__ void chunk_prep_pair(Frame& F, int pair) {
    int lane_ = F.lane; asm volatile("" : "+v"(lane_));
    const int half = F.tid >> 8, ht = F.tid & 255, hw = F.wave & 3, lane = lane_;
    const int unit = pair * 2 + half;
    const int bh = unit >> 7, c = unit & (NCHUNK - 1), b = bh >> 2, h = bh & 3;
    const int row0 = b * SEQ + c * 64;
    LAS unsigned char* L = F.lds + half * CP_HALF;
    LAS float* AM = (LAS float*)(L + CP_AM); LAS float* GC = (LAS float*)(L + CP_GC); LAS float* BETA = (LAS float*)(L + CP_BETA); LAS float* EG = (LAS float*)(L + CP_EG);
    unsigned char* chk = F.ws + WS_CHK + (size_t)unit * CHK_BYTES;
    if (hw == 0) {
        float g = F.GB[(size_t)(row0 + lane) * 8 + h]; const float be = F.GB[(size_t)(row0 + lane) * 8 + 4 + h];
#pragma unroll
        for (int o = 1; o < 64; o <<= 1) { const float t = __shfl_up(g, o); if (lane >= o) g += t; }
        GC[lane] = g; BETA[lane] = be; EG[lane] = __expf(g);
        if (lane == 63) ((float*)(F.ws + WS_GL))[unit] = __expf(g);
    }
    {
        const float* cw = F.in[I_CONVW];
        float wq[4][2], wk[4][2], wv[4][2];
#pragma unroll
        for (int j = 0; j < 4; ++j) { const float2 a = *(const float2*)(cw + j * CONVCH + h * 128 + 2 * lane), bq = *(const float2*)(cw + j * CONVCH + 512 + h * 128 + 2 * lane), cq = *(const float2*)(cw + j * CONVCH + 1024 + h * 128 + 2 * lane);
            wq[j][0] = a.x; wq[j][1] = a.y; wk[j][0] = bq.x; wk[j][1] = bq.y; wv[j][0] = cq.x; wv[j][1] = cq.y; }
        float xq[3][2], xk[3][2], xv[3][2];
        const int tok0 = c * 64 + hw * 16;
#pragma unroll
        for (int j = 0; j < 3; ++j) { const int tp = tok0 - 3 + j; unsigned a = 0u, bq = 0u, cq = 0u;
            if (tp >= 0) { const bf16* pr = F.PROJ + (size_t)(b * SEQ + tp) * NPROJ + h * 128 + 2 * lane; a = *(const unsigned*)pr; bq = *(const unsigned*)(pr + 512); cq = *(const unsigned*)(pr + 1024); }
            xq[j][0] = bflo(a); xq[j][1] = bfhi(a); xk[j][0] = bflo(bq); xk[j][1] = bfhi(bq); xv[j][0] = bflo(cq); xv[j][1] = bfhi(cq); }
#pragma unroll 4
        for (int tt = 0; tt < 16; ++tt) {
            const int tl = hw * 16 + tt;
            const bf16* pr = F.PROJ + (size_t)(row0 + tl) * NPROJ + h * 128 + 2 * lane;
            const unsigned a = *(const unsigned*)pr, bq = *(const unsigned*)(pr + 512), cq = *(const unsigned*)(pr + 1024);
            const float nq0 = bflo(a), nq1 = bfhi(a), nk0 = bflo(bq), nk1 = bfhi(bq), nv0 = bflo(cq), nv1 = bfhi(cq);
            float yq0 = wq[0][0] * xq[0][0] + wq[1][0] * xq[1][0] + wq[2][0] * xq[2][0] + wq[3][0] * nq0, yq1 = wq[0][1] * xq[0][1] + wq[1][1] * xq[1][1] + wq[2][1] * xq[2][1] + wq[3][1] * nq1;
            float yk0 = wk[0][0] * xk[0][0] + wk[1][0] * xk[1][0] + wk[2][0] * xk[2][0] + wk[3][0] * nk0, yk1 = wk[0][1] * xk[0][1] + wk[1][1] * xk[1][1] + wk[2][1] * xk[2][1] + wk[3][1] * nk1;
            float yv0 = wv[0][0] * xv[0][0] + wv[1][0] * xv[1][0] + wv[2][0] * xv[2][0] + wv[3][0] * nv0, yv1 = wv[0][1] * xv[0][1] + wv[1][1] * xv[1][1] + wv[2][1] * xv[2][1] + wv[3][1] * nv1;
#pragma unroll
            for (int e = 0; e < 2; ++e) { xq[0][e] = xq[1][e]; xq[1][e] = xq[2][e]; xk[0][e] = xk[1][e]; xk[1][e] = xk[2][e]; xv[0][e] = xv[1][e]; xv[1][e] = xv[2][e]; }
            xq[2][0] = nq0; xq[2][1] = nq1; xk[2][0] = nk0; xk[2][1] = nk1; xv[2][0] = nv0; xv[2][1] = nv1;
            yq0 = siluf(yq0); yq1 = siluf(yq1); yk0 = siluf(yk0); yk1 = siluf(yk1); yv0 = siluf(yv0); yv1 = siluf(yv1);
            const float qn = (1.f / sqrtf(wave_sum(yq0 * yq0 + yq1 * yq1) + NORM_EPS)) * 0.08838834764831845f, kn = 1.f / sqrtf(wave_sum(yk0 * yk0 + yk1 * yk1) + NORM_EPS);
            *(LAS unsigned*)(L + CP_QB + tl * CP_ROWB + 4 * lane) = cvtpk(yq0 * qn, yq1 * qn);
            *(LAS unsigned*)(L + CP_KB + tl * CP_ROWB + 4 * lane) = cvtpk(yk0 * kn, yk1 * kn);
            *(LAS unsigned*)(L + CP_VB + tl * CP_ROWB + 4 * lane) = cvtpk(yv0, yv1);
        }
    }
    __syncthreads();
    {
        const int r = lane & 31, hh = lane >> 5;
        f32x16 zero; for (int i = 0; i < 16; ++i) zero[i] = 0.f;
        const int njobs = 2;
#pragma unroll
        for (int job = 0; job < njobs; ++job) {
            int ta, tb; bool isz = false;
            if (hw == 0 || hw == 2) { ta = job; tb = job; } else if (hw == 1) { ta = job == 0 ? 1 : 0; tb = job == 0 ? 0 : 1; isz = job == 1; } else { ta = job == 0 ? 0 : 1; tb = job == 0 ? 1 : 0; isz = job == 1; }
            f32x16 acc = zero;
            if (!isz) {
                const int srcB = (hw < 2) ? CP_KB : CP_QB;
#pragma unroll
                for (int ks = 0; ks < 8; ++ks) {
                    const bf16x8 fa = *(const LAS bf16x8*)(L + CP_KB + (32 * ta + r) * CP_ROWB + (16 * ks + 8 * hh) * 2);
                    const bf16x8 fb = *(const LAS bf16x8*)(L + srcB + (32 * tb + r) * CP_ROWB + (16 * ks + 8 * hh) * 2);
                    acc = MFMA32(fa, fb, acc);
                }
            }
            if (hw < 2) {
                const int j = 32 * tb + r; const float gj = GC[j];
#pragma unroll
                for (int q = 0; q < 16; ++q) { const int i = 32 * ta + crow(q, hh); const float v = (i > j) ? acc[q] * BETA[i] * __expf(GC[i] - gj) : 0.f; AM[i * 64 + j] = v; }
            } else {
                const int i = 32 * tb + r; const float gi = GC[i];
                f32x16 x;
#pragma unroll
                for (int q = 0; q < 16; ++q) { const int j = 32 * ta + crow(q, hh); x[q] = (i >= j) ? acc[q] * __expf(gi - GC[j]) : 0.f; }
#pragma unroll
                for (int s = 0; s < 2; ++s) *(bf16x8*)(chk + CHK_AF + ((tb * 4 + 2 * ta + s) * 64 + lane) * 16) = pack8(x, s);
            }
        }
    }
    {
        const float gl_last = GC[63];
#pragma unroll
        for (int rep = 0; rep < 4; ++rep) {
            const int item = rep * 256 + ht, fl = item & 63, fr = item >> 6, m = fr >> 3, ks = fr & 7, r = fl & 31, hh = fl >> 5;
            const int i = 32 * m + r, col = 32 * (ks >> 1) + 16 * (ks & 1) + 4 * hh; const float e = EG[i];
            const v2u lo = *(const LAS v2u*)(L + CP_QB + i * CP_ROWB + col * 2), hi = *(const LAS v2u*)(L + CP_QB + i * CP_ROWB + (col + 8) * 2);
            v4u o; o.x = cvtpk(bflo(lo.x) * e, bfhi(lo.x) * e); o.y = cvtpk(bflo(lo.y) * e, bfhi(lo.y) * e); o.z = cvtpk(bflo(hi.x) * e, bfhi(hi.x) * e); o.w = cvtpk(bflo(hi.y) * e, bfhi(hi.y) * e);
            *(v4u*)(chk + CHK_QF + (size_t)item * 16) = o;
        }
#pragma unroll
        for (int rep = 0; rep < 4; ++rep) {
            const int item = rep * 256 + ht, fl = item & 63, fr = item >> 6, mt = fr >> 2, ks = fr & 3, r = fl & 31, hh = fl >> 5;
            const int dk = 32 * mt + r, j0 = 32 * (ks >> 1) + 16 * (ks & 1) + 4 * hh;
            float v[8];
#pragma unroll
            for (int jj = 0; jj < 8; ++jj) { const int j = j0 + 8 * (jj >> 2) + (jj & 3); v[jj] = bf2f(*(const LAS bf16*)(L + CP_KB + j * CP_ROWB + dk * 2)) * __expf(gl_last - GC[j]); }
            v4u o; o.x = cvtpk(v[0], v[1]); o.y = cvtpk(v[2], v[3]); o.z = cvtpk(v[4], v[5]); o.w = cvtpk(v[6], v[7]);
            *(v4u*)(chk + CHK_KF + (size_t)item * 16) = o;
        }
    }
    float x[64];
    {
        const int cc = ht & 127; const int src = (ht < 128) ? CP_VB : CP_KB;
#pragma unroll
        for (int i = 0; i < 64; ++i) { const float sc = (ht < 128) ? BETA[i] : BETA[i] * EG[i]; x[i] = bf2f(*(const LAS bf16*)(L + src + i * CP_ROWB + cc * 2)) * sc; }
    }
    __syncthreads();
#pragma unroll
    for (int i = 1; i < 64; ++i) {
        float acc0 = 0.f, acc1 = 0.f;
#pragma unroll
        for (int j4 = 0; j4 < (i + 3) / 4; ++j4) {
            const f32x4 a = *(const LAS f32x4*)(AM + i * 64 + 4 * j4);
            acc0 += a.x * x[4 * j4] + a.z * x[4 * j4 + 2]; acc1 += a.y * x[4 * j4 + 1] + a.w * x[4 * j4 + 3];
        }
        x[i] -= acc0 + acc1;
    }
    if (ht < 128) {
        v4u* dst = (v4u*)(F.ws + WS_UT + ((size_t)unit * 128 + ht) * 128);
#pragma unroll
        for (int mh = 0; mh < 4; ++mh) { const int m = mh >> 1, hh = mh & 1;
#pragma unroll
            for (int p = 0; p < 2; ++p) { v4u o;
                o.x = cvtpk(x[32 * m + crow(8 * p + 0, hh)], x[32 * m + crow(8 * p + 1, hh)]); o.y = cvtpk(x[32 * m + crow(8 * p + 2, hh)], x[32 * m + crow(8 * p + 3, hh)]);
                o.z = cvtpk(x[32 * m + crow(8 * p + 4, hh)], x[32 * m + crow(8 * p + 5, hh)]); o.w = cvtpk(x[32 * m + crow(8 * p + 6, hh)], x[32 * m + crow(8 * p + 7, hh)]);
                dst[mh * 2 + p] = o; } }
    } else {
        const int cc = ht - 128;
#pragma unroll
        for (int i = 0; i < 64; ++i) *(LAS bf16*)(L + CP_QB + i * CP_ROWB + cc * 2) = (bf16)(cvtpk(x[i], 0.f) & 0xffffu);
    }
    __syncthreads();
#pragma unroll
    for (int rep = 0; rep < 4; ++rep) {
        const int item = rep * 256 + ht, fl = item & 63, fr = item >> 6, m = fr >> 3, ks = fr & 7, r = fl & 31, hh = fl >> 5;
        const int i = 32 * m + r, col = 32 * (ks >> 1) + 16 * (ks & 1) + 4 * hh;
        const v2u lo = *(const LAS v2u*)(L + CP_QB + i * CP_ROWB + col * 2), hi = *(const LAS v2u*)(L + CP_QB + i * CP_ROWB + (col + 8) * 2);
        v4u o; o.x = lo.x; o.y = lo.y; o.z = hi.x; o.w = hi.y;
        *(v4u*)(chk + CHK_WF + (size_t)item * 16) = o;
    }
    __syncthreads();
}

__device__ __forceinline__ void dn_scan_unit(Frame& F, int bh) {
    int lane_ = threadIdx.x & 63; asm volatile("" : "+v"(lane_));
    const int lane = lane_, wave = F.wave, r = lane & 31, hh = lane >> 5;
    const int b = bh >> 2, h = bh & 3;
    const unsigned char* chk0 = F.ws + WS_CHK + (size_t)bh * NCHUNK * CHK_BYTES;
#define SCAN_BAR() do { asm volatile("s_waitcnt lgkmcnt(0)" ::: "memory"); __builtin_amdgcn_s_barrier(); asm volatile("" ::: "memory"); } while (0)
    if (wave >= 4) {
        const int lt = F.tid - 256;
        v4u ra[14], rb[14];
#pragma unroll
        for (int i = 0; i < 14; ++i) ra[i] = *(const v4u*)(chk0 + (size_t)(i * 256 + lt) * 16);
#pragma unroll
        for (int i = 0; i < 14; ++i) rb[i] = *(const v4u*)(chk0 + CHK_BYTES + (size_t)(i * 256 + lt) * 16);
#pragma unroll
        for (int i = 0; i < 14; ++i) *(LAS v4u*)(F.lds + (i * 256 + lt) * 16) = ra[i];
        SCAN_BAR();
        for (int c = 0; c < NCHUNK; c += 2) {
#pragma unroll
            for (int i = 0; i < 14; ++i) *(LAS v4u*)(F.lds + CHK_BYTES + (i * 256 + lt) * 16) = rb[i];
            if (c + 2 < NCHUNK) {
#pragma unroll
                for (int i = 0; i < 14; ++i) ra[i] = *(const v4u*)(chk0 + (size_t)(c + 2) * CHK_BYTES + (size_t)(i * 256 + lt) * 16);
            }
            SCAN_BAR();
            if (c + 2 < NCHUNK) {
#pragma unroll
                for (int i = 0; i < 14; ++i) *(LAS v4u*)(F.lds + (i * 256 + lt) * 16) = ra[i];
            }
            if (c + 3 < NCHUNK) {
#pragma unroll
                for (int i = 0; i < 14; ++i) rb[i] = *(const v4u*)(chk0 + (size_t)(c + 3) * CHK_BYTES + (size_t)(i * 256 + lt) * 16);
            }
            SCAN_BAR();
        }
    } else {
        const int n0 = wave * 32;
        f32x16 S[4];
#pragma unroll
        for (int mt = 0; mt < 4; ++mt)
#pragma unroll
            for (int i = 0; i < 16; ++i) S[mt][i] = 0.f;
        const unsigned char* ut0 = F.ws + WS_UT + ((size_t)bh * NCHUNK * 128 + n0 + r) * 128 + hh * 32;
        const float* gl0 = (const float*)(F.ws + WS_GL) + bh * NCHUNK;
        v4u un[4];
#pragma unroll
        for (int m = 0; m < 2; ++m) { un[2 * m] = *(const v4u*)(ut0 + m * 64); un[2 * m + 1] = *(const v4u*)(ut0 + m * 64 + 16); }
        SCAN_BAR();
        for (int c = 0; c < NCHUNK; ++c) {
            LAS unsigned char* slot = F.lds + (c & 1) * CHK_BYTES;
            const float gl = gl0[c];
            f32x16 ws[2], qs[2];
#pragma unroll
            for (int m = 0; m < 2; ++m)
#pragma unroll
                for (int i = 0; i < 16; ++i) { ws[m][i] = 0.f; qs[m][i] = 0.f; }
#pragma unroll
            for (int ks = 0; ks < 8; ++ks) {
                const bf16x8 bS = pack8(S[ks >> 1], ks & 1);
#pragma unroll
                for (int m = 0; m < 2; ++m) {
                    const bf16x8 aw = *(const LAS bf16x8*)(slot + CHK_WF + ((m * 8 + ks) * 64 + lane) * 16);
                    const bf16x8 aq = *(const LAS bf16x8*)(slot + CHK_QF + ((m * 8 + ks) * 64 + lane) * 16);
                    ws[m] = MFMA32(aw, bS, ws[m]); qs[m] = MFMA32(aq, bS, qs[m]);
                }
            }
#pragma unroll
            for (int m = 0; m < 2; ++m) {
                const v4u u0 = un[2 * m], u1 = un[2 * m + 1];
                ws[m][0] = bflo(u0.x) - ws[m][0]; ws[m][1] = bfhi(u0.x) - ws[m][1]; ws[m][2] = bflo(u0.y) - ws[m][2]; ws[m][3] = bfhi(u0.y) - ws[m][3];
                ws[m][4] = bflo(u0.z) - ws[m][4]; ws[m][5] = bfhi(u0.z) - ws[m][5]; ws[m][6] = bflo(u0.w) - ws[m][6]; ws[m][7] = bfhi(u0.w) - ws[m][7];
                ws[m][8] = bflo(u1.x) - ws[m][8]; ws[m][9] = bfhi(u1.x) - ws[m][9]; ws[m][10] = bflo(u1.y) - ws[m][10]; ws[m][11] = bfhi(u1.y) - ws[m][11];
                ws[m][12] = bflo(u1.z) - ws[m][12]; ws[m][13] = bfhi(u1.z) - ws[m][13]; ws[m][14] = bflo(u1.w) - ws[m][14]; ws[m][15] = bfhi(u1.w) - ws[m][15];
            }
            if (c + 1 < NCHUNK) {
#pragma unroll
                for (int m = 0; m < 2; ++m) { un[2 * m] = *(const v4u*)(ut0 + (size_t)(c + 1) * 16384 + m * 64); un[2 * m + 1] = *(const v4u*)(ut0 + (size_t)(c + 1) * 16384 + m * 64 + 16); }
            }
            bf16x8 vb[4];
#pragma unroll
            for (int k = 0; k < 4; ++k) vb[k] = pack8(ws[k >> 1], k & 1);
#pragma unroll
            for (int k = 0; k < 4; ++k)
#pragma unroll
                for (int m = 0; m < 2; ++m) { const bf16x8 aa = *(const LAS bf16x8*)(slot + CHK_AF + ((m * 4 + k) * 64 + lane) * 16); qs[m] = MFMA32(aa, vb[k], qs[m]); }
            {
                float* orow = F.OA + (size_t)(b * SEQ + c * 64 + 4 * hh) * 512 + h * 128 + n0 + r;
                asm volatile("" : "+v"(orow));
#pragma unroll
                for (int m = 0; m < 2; ++m)
#pragma unroll
                    for (int i = 0; i < 16; ++i) orow[(32 * m + (i & 3) + 8 * (i >> 2)) * 512] = qs[m][i];
            }
#pragma unroll
            for (int mt = 0; mt < 4; ++mt) {
                S[mt] = S[mt] * gl;
#pragma unroll
                for (int k = 0; k < 4; ++k) { const bf16x8 ak = *(const LAS bf16x8*)(slot + CHK_KF + ((mt * 4 + k) * 64 + lane) * 16); S[mt] = MFMA32(ak, vb[k], S[mt]); }
            }
            SCAN_BAR();
        }
        float* so = F.out + O_DELTAP + (size_t)bh * 16384 + (4 * hh) * 128 + n0 + r;
#pragma unroll
        for (int mt = 0; mt < 4; ++mt)
#pragma unroll
            for (int i = 0; i < 16; ++i) so[(32 * mt + (i & 3) + 8 * (i >> 2)) * 128] = S[mt][i];
    }
#undef SCAN_BAR
    __syncthreads();
}

#ifndef MK_N_LAUNCHES
#define MK_N_LAUNCHES 1
#endif
constexpr int N_PHASES = 7, N_LAUNCHES = MK_N_LAUNCHES;
__global__ void __launch_bounds__(NTHR, 2) hymba_fwd(Args args) {
    extern __shared__ __attribute__((aligned(16))) unsigned char lds[];
    Frame F;
    F.lds = (LAS unsigned char*)lds;
    F.tid = threadIdx.x; F.lane = F.tid & 63; F.wave = __builtin_amdgcn_readfirstlane(F.tid >> 6); F.G = gridDim.x;
#pragma unroll
    for (int i = 0; i < 14; ++i) F.in[i] = args.in[i];
    F.out = args.out; F.ws = args.ws;
    F.WinT = (bf16*)(args.ws + WS_WIN); F.WoutT = (bf16*)(args.ws + WS_WOUT); F.XN = (bf16*)(args.ws + WS_XN); F.PROJ = (bf16*)(args.ws + WS_PROJ); F.MIX = (bf16*)(args.ws + WS_MIX);
    F.GB = (float*)(args.ws + WS_GB); F.OA = (float*)(args.ws + WS_OA);
    volatile LAS unsigned* MISC = (volatile LAS unsigned*)(F.lds + MISC_OFF);
    if (F.tid < 64) ((LAS unsigned*)(F.lds + MISC_OFF))[F.tid] = 0u;
    __syncthreads();
    unsigned* barw = (unsigned*)(args.ws + WS_CTL) + CW_BAR;
    XcdBarrier bar; bar.bar = barw; bar.x = 0; bar.st = nullptr;
    if (N_LAUNCHES == 1) bar = xcd_barrier_post(barw, MISC + 8);
    const int lo = args.ph_lo, hi = args.ph_hi;
#define IN(k) (lo <= (k) && (k) < hi)
#define BOTH(k) (IN(k) && IN((k) + 1))
#define GRID_BAR() do { if (N_LAUNCHES == 1) xcd_barrier(bar); } while (0)

    if (IN(0)) { p0_prologue(F); if (BOTH(0)) GRID_BAR(); }
    if (IN(1)) {
        pg8::Gemm g{F.XN, F.WinT, MT, NPROJ, DM}; pg8::StaticOrder S; S.init(MT, NPROJ, F.G, (int)blockIdx.x);
        pg8::EpiBf16 E{F.PROJ, NPROJ};
        pg8::gemm_phase<pg8::EpiBf16, pg8::StaticOrder, true, true>(F.lds, g, S, E);
        if (BOTH(1)) GRID_BAR();
    }
    if (IN(2)) {
        for (int p = blockIdx.x; p < NUNIT / 2; p += F.G) chunk_prep_pair(F, p);
        for (int u = 16 + blockIdx.x; u < 16 + SB * 4; u += F.G) dn_seq_unit(F, u);
        if (BOTH(2)) GRID_BAR();
    }
    if (IN(3)) { if (blockIdx.x < 16) dn_scan_unit(F, blockIdx.x); attn_simple(F); copy_outputs(F); if (BOTH(3)) GRID_BAR(); }
    if (IN(4)) { mix_a_finish(F); if (BOTH(4)) GRID_BAR(); }
    if (IN(5)) {
        pg8::Gemm g{F.MIX, F.WoutT, MT, DM, DM}; pg8::StaticOrder S; S.init(MT, DM, F.G, (int)blockIdx.x);
        pg8::EpiResF32 E{F.in[I_XP], F.in[I_XS], NP, F.out, DM};
        pg8::gemm_phase<pg8::EpiResF32, pg8::StaticOrder, true, true>(F.lds, g, S, E);
        if (BOTH(5)) GRID_BAR();
    }
    if (IN(6)) { final_norm(F); }
#undef IN
#undef BOTH
}

extern "C" void kernel_launch(void* const* d_in, const int* in_sizes, int n_in, void* d_out, int out_size, void* d_ws, size_t ws_size, hipStream_t stream) {
    static int grid = 0;
    if (grid == 0) {
        if (n_in != 14 || (size_t)out_size != O_END || ws_size < WS_END) { fprintf(stderr, "kernel_launch: unexpected shapes (n_in %d, out %d, ws %zu); nothing launched\n", n_in, out_size, ws_size); grid = -1; return; }
        int dev = 0, cus = 0, per_cu = 0;
        if (hipGetDevice(&dev) != hipSuccess || hipDeviceGetAttribute(&cus, hipDeviceAttributeMultiprocessorCount, dev) != hipSuccess) { grid = -1; return; }
        if (hipFuncSetAttribute((const void*)hymba_fwd, hipFuncAttributeMaxDynamicSharedMemorySize, LDS_BYTES) != hipSuccess) { fprintf(stderr, "kernel_launch: hipFuncSetAttribute failed\n"); grid = -1; return; }
        if (hipOccupancyMaxActiveBlocksPerMultiprocessor(&per_cu, (const void*)hymba_fwd, NTHR, LDS_BYTES) != hipSuccess || per_cu < 1) fprintf(stderr, "kernel_launch: occupancy query says %d\n", per_cu);
        (void)hipGetLastError();
        grid = cus;
    }
    if (grid < 0) return;
    if (hipMemsetAsync((char*)d_ws + WS_CTL, 0, CTL_ZERO_BYTES, stream) != hipSuccess) return;
    Args a{};
    for (int i = 0; i < 14; ++i) a.in[i] = (const float*)d_in[i];
    a.out = (float*)d_out; a.ws = (unsigned char*)d_ws;
    if (N_LAUNCHES == 1) { a.ph_lo = 0; a.ph_hi = N_PHASES; hipLaunchKernelGGL(hymba_fwd, dim3(grid), dim3(NTHR), LDS_BYTES, stream, a); }
    else for (int li = 0; li < N_PHASES; ++li) { a.ph_lo = li; a.ph_hi = li + 1; hipLaunchKernelGGL(hymba_fwd, dim3(grid), dim3(NTHR), LDS_BYTES, stream, a); }
}
```

```cpp
#include <hip/hip_runtime.h>
#include <cstdio>
#include <cstdint>
namespace pg8 {
#define PG8_LAS __attribute__((address_space(3)))
typedef unsigned short bf16_t;
typedef short bf16x8 __attribute__((ext_vector_type(8)));
typedef float f32x4 __attribute__((ext_vector_type(4)));
typedef unsigned u32x4 __attribute__((ext_vector_type(4)));
constexpr int BM = 256, BK = 64, HALF = 128, HTB = HALF * BK * 2  , STAGE_BYTES = 8 * HTB, NXCD = 8, WGM = 8;

__host__ __device__ __forceinline__ int lds_byte(int r, int c) { const int st = (r >> 4) * 2 + (c >> 5), rr = r & 15, cc = c & 31, ob = rr * 64 + cc * 2; return st * 1024 + (ob ^ (((ob >> 9) & 1) << 5)); }
__host__ __device__ __forceinline__ void stage_rc(int b, int& R, int& C) { const int st = b / 1024, sb = b % 1024, swz = sb ^ (((sb >> 9) & 1) << 5); R = (st >> 1) * 16 + swz / 64; C = (st & 1) * 32 + (swz % 64) / 2; }
__host__ __device__ __forceinline__ int perm32(int rho) { const int n = rho >> 4, i = rho & 15; return 8 * (i >> 2) + 4 * n + (i & 3); }

struct Unit { int pm, pn; };
struct Gemm { const bf16_t* A; const bf16_t* Bt; int M, N, K; };

struct StaticOrder {
    int nM, nN, nwg, G, c;
    __host__ __device__ void init(int M, int N, int G_, int c_) { nM = M / BM; nN = N / BM; nwg = nM * nN; G = G_; c = c_; }
    __host__ __device__ bool next(int i, Unit& u) const {
        const long L = (long)i * G + c; if (L >= nwg) return false;
        int wgid = (int)L; { const int q = nwg / NXCD, r = nwg % NXCD, xcd = wgid % NXCD, off = wgid / NXCD; wgid = (xcd < r ? xcd * (q + 1) : r * (q + 1) + (xcd - r) * q) + off; }
        const int nig = WGM * nN, gid = wgid / nig, fm = gid * WGM, gsz = (nM - fm) < WGM ? (nM - fm) : WGM;
        u.pm = fm + ((wgid % nig) % gsz); u.pn = (wgid % nig) / gsz; return true;
    }
    __device__ __forceinline__ void a_ready(const Unit&) const {}
    __device__ __forceinline__ void done(const Unit&) const {}
};

__device__ __forceinline__ unsigned cvt_pk_bf16(float lo, float hi) { unsigned r; asm volatile("v_cvt_pk_bf16_f32 %0, %1, %2" : "=v"(r) : "v"(lo), "v"(hi)); return r; }
typedef float f32x2 __attribute__((ext_vector_type(2)));
struct EpiBf16 {
    static constexpr bool PERM = true, AFTER_DRAIN = false;
    bf16_t* O; int ldc;
    __device__ __forceinline__ void operator()(const f32x4 (&acc)[2][2][4][2], const Unit& u, int wr, int wc, int fr, int fq) const {
        const int row0 = u.pm * BM + wr * 64 + fr; const int col0 = u.pn * BM + wc * 32 + 8 * fq;
#pragma unroll
        for (int ai = 0; ai < 2; ++ai)
#pragma unroll
            for (int m = 0; m < 4; ++m) { bf16_t* rowp = O + (size_t)(row0 + ai * HALF + m * 16) * ldc + col0;
#pragma unroll
                for (int bj = 0; bj < 2; ++bj) { const f32x4 v0 = acc[ai][bj][m][0], v1 = acc[ai][bj][m][1];
                    u32x4 w; w.x = cvt_pk_bf16(v0[0], v0[1]); w.y = cvt_pk_bf16(v0[2], v0[3]); w.z = cvt_pk_bf16(v1[0], v1[1]); w.w = cvt_pk_bf16(v1[2], v1[3]);
                    *(u32x4*)(rowp + bj * HALF) = w; } }
    }
};
struct EpiResF32 {
    static constexpr bool PERM = false, AFTER_DRAIN = false;
    const float* res0; const float* res1; int rows0; float* out; int ldc;
    __device__ __forceinline__ void operator()(const f32x4 (&acc)[2][2][4][2], const Unit& u, int wr, int wc, int fr, int fq) const {
        const int col0 = u.pn * BM + wc * 32 + 4 * fq;
#pragma unroll
        for (int ai = 0; ai < 2; ++ai)
#pragma unroll
            for (int m = 0; m < 4; ++m) { const int row = u.pm * BM + ai * HALF + wr * 64 + m * 16 + fr;
                const float* rp = (row < rows0 ? res0 + (size_t)row * ldc : res1 + (size_t)(row - rows0) * ldc) + col0;
                float* op = out + (size_t)row * ldc + col0;
#pragma unroll
                for (int bj = 0; bj < 2; ++bj)
#pragma unroll
                    for (int n = 0; n < 2; ++n) { const f32x4 r = *(const f32x4*)(rp + bj * HALF + n * 16); *(f32x4*)(op + bj * HALF + n * 16) = acc[ai][bj][m][n] + r; } }
    }
};
template <class Epi, class Sched, bool ALIGN_EPI = false, bool SP2 = false>
__device__ __forceinline__ void gemm_phase(PG8_LAS unsigned char* lds, const Gemm g, const Sched& S, const Epi& E) {
    const int tid = threadIdx.x, wid = __builtin_amdgcn_readfirstlane(tid >> 6), lane = tid & 63, wr = wid >> 2, wc = wid & 3, fr = lane & 15, fq = lane >> 4;
    const int K = g.K, nt = K / BK;
    unsigned voffA[2], voffB[2];
#pragma unroll
    for (int i = 0; i < 2; ++i) { int R, C; stage_rc(tid * 16 + i * 8192, R, C); const int Rb = Epi::PERM ? ((R & ~31) + perm32(R & 31)) : R;
        voffA[i] = (unsigned)(R * K + C) * 2u; voffB[i] = (unsigned)(Rb * K + C) * 2u; }
    const size_t kstep = (size_t)(BK * 2);
    const size_t hstep = (size_t)HALF * K * 2;
    const size_t tstep = 2 * hstep;
    const unsigned ldsw = (unsigned)wid * 1024u;
    const int aoff = lds_byte(wr * 64 + fr, fq * 8), boff = lds_byte(wc * 32 + fr, fq * 8);
#define PG8_SA(b, h) (((b) * 2 + (h)) * HTB)
#define PG8_SB(b, h) ((4 + (b) * 2 + (h)) * HTB)
#define PG8_STAGE(bufoff, gbase, voff) do { _Pragma("unroll") for (int _i = 0; _i < 2; ++_i) \
        __builtin_amdgcn_global_load_lds((const unsigned*)((const char*)(gbase) + (voff)[_i]), (PG8_LAS unsigned*)(lds + (bufoff) + ldsw + _i * 8192), 16, 0, 0); } while (0)
#define PG8_LDA(dst, b, h) do { _Pragma("unroll") for (int m = 0; m < 4; ++m) _Pragma("unroll") for (int k = 0; k < 2; ++k) dst[m][k] = *(const PG8_LAS bf16x8*)(lds + PG8_SA(b, h) + aoff + m * 2048 + k * 1024); } while (0)
#define PG8_LDB(dst, b, h) do { _Pragma("unroll") for (int n = 0; n < 2; ++n) _Pragma("unroll") for (int k = 0; k < 2; ++k) dst[n][k] = *(const PG8_LAS bf16x8*)(lds + PG8_SB(b, h) + boff + n * 2048 + k * 1024); } while (0)
#define PG8_MMA(ai, bj, At, Bt) do { __builtin_amdgcn_s_setprio(1); _Pragma("unroll") for (int m = 0; m < 4; ++m) _Pragma("unroll") for (int n = 0; n < 2; ++n) _Pragma("unroll") for (int k = 0; k < 2; ++k) \
        acc[ai][bj][m][n] = __builtin_amdgcn_mfma_f32_16x16x32_bf16(Bt[n][k], At[m][k], acc[ai][bj][m][n], 0, 0, 0); __builtin_amdgcn_s_setprio(0); } while (0)
#define PG8_WAIT_V(n) asm volatile("s_waitcnt vmcnt(" #n ")" ::: "memory")
#define PG8_WAIT_L(n) asm volatile("s_waitcnt lgkmcnt(" #n ")" ::: "memory")
#define PG8_BAR __builtin_amdgcn_s_barrier()
#define PG8_SCHED __builtin_amdgcn_sched_barrier(0)
    Unit cur, nxt; int ui = 0;
    if (!S.next(0, cur)) return;
    f32x4 acc[2][2][4][2];
#pragma unroll
    for (int a = 0; a < 2; ++a)
#pragma unroll
        for (int b = 0; b < 2; ++b)
#pragma unroll
            for (int m = 0; m < 4; ++m)
#pragma unroll
                for (int n = 0; n < 2; ++n) acc[a][b][m][n] = (f32x4){0.f, 0.f, 0.f, 0.f};
    bf16x8 At[4][2], B0[2][2], B1[2][2];
    const char* cA = (const char*)g.A + (size_t)cur.pm * tstep; const char* cB = (const char*)g.Bt + (size_t)cur.pn * tstep;
    S.a_ready(cur);
    if constexpr (SP2) {
        PG8_STAGE(PG8_SB(0, 0), cB, voffB); PG8_STAGE(PG8_SB(0, 1), cB + hstep, voffB); PG8_STAGE(PG8_SA(0, 0), cA, voffA); PG8_STAGE(PG8_SA(0, 1), cA + hstep, voffA);
        if (wr == 1) PG8_BAR;
        PG8_WAIT_V(2); PG8_BAR;
        PG8_STAGE(PG8_SB(1, 0), cB + kstep, voffB); PG8_STAGE(PG8_SA(1, 0), cA + kstep, voffA); PG8_STAGE(PG8_SB(1, 1), cB + hstep + kstep, voffB);
        PG8_WAIT_V(6); PG8_BAR;
    } else {
        PG8_STAGE(PG8_SB(0, 0), cB, voffB); PG8_STAGE(PG8_SA(0, 0), cA, voffA); PG8_STAGE(PG8_SB(0, 1), cB + hstep, voffB); PG8_STAGE(PG8_SA(0, 1), cA + hstep, voffA);
        if (wr == 1) PG8_BAR;
        PG8_WAIT_V(4); PG8_BAR;
        PG8_STAGE(PG8_SB(1, 0), cB + kstep, voffB); PG8_STAGE(PG8_SA(1, 0), cA + kstep, voffA); PG8_STAGE(PG8_SB(1, 1), cB + hstep + kstep, voffB);
        PG8_WAIT_V(6); PG8_BAR;
    }
    for (;;) {
        const bool has_next = S.next(ui + 1, nxt);
        const char* nA = has_next ? (const char*)g.A + (size_t)nxt.pm * tstep : cA; const char* nB = has_next ? (const char*)g.Bt + (size_t)nxt.pn * tstep : cB;
        for (int t = 0; t < nt; t += 2) {
            const bool last = (t == nt - 2);
            const char* a1 = cA + (size_t)(t + 1) * kstep;
            const char* a2 = last ? nA : cA + (size_t)(t + 2) * kstep; const char* b2 = last ? nB : cB + (size_t)(t + 2) * kstep;
            const char* a3 = a2 + kstep; const char* b3 = b2 + kstep;
            if (last && has_next) S.a_ready(nxt);
            if constexpr (SP2) {
            PG8_LDB(B0, 0, 0); PG8_LDB(B1, 0, 1); PG8_SCHED; PG8_LDA(At, 0, 0); PG8_STAGE(PG8_SA(1, 1), a1 + hstep, voffA);
            PG8_WAIT_V(8); PG8_WAIT_L(0); PG8_BAR; PG8_MMA(0, 0, At, B0); PG8_MMA(0, 1, At, B1); PG8_BAR; PG8_SCHED;
            PG8_LDA(At, 0, 1); PG8_STAGE(PG8_SB(0, 0), b2, voffB); PG8_STAGE(PG8_SB(0, 1), b2 + hstep, voffB); PG8_STAGE(PG8_SA(0, 0), a2, voffA);
            PG8_WAIT_V(8); PG8_WAIT_L(0); PG8_BAR; PG8_MMA(1, 0, At, B0); PG8_MMA(1, 1, At, B1); PG8_BAR; PG8_SCHED;
            PG8_LDB(B0, 1, 0); PG8_LDB(B1, 1, 1); PG8_SCHED; PG8_LDA(At, 1, 0); PG8_STAGE(PG8_SA(0, 1), a2 + hstep, voffA);
            PG8_WAIT_V(8); PG8_WAIT_L(0); PG8_BAR; PG8_MMA(0, 0, At, B0); PG8_MMA(0, 1, At, B1); PG8_BAR; PG8_SCHED;
            PG8_LDA(At, 1, 1); PG8_STAGE(PG8_SB(1, 0), b3, voffB); PG8_STAGE(PG8_SB(1, 1), b3 + hstep, voffB); PG8_STAGE(PG8_SA(1, 0), a3, voffA);
            PG8_WAIT_V(8); PG8_WAIT_L(0); PG8_BAR; PG8_MMA(1, 0, At, B0); PG8_MMA(1, 1, At, B1); PG8_BAR; PG8_SCHED;
            } else {
            PG8_LDB(B0, 0, 0); PG8_SCHED; PG8_LDA(At, 0, 0); PG8_STAGE(PG8_SA(1, 1), a1 + hstep, voffA);
            PG8_WAIT_L(8); PG8_BAR; PG8_WAIT_L(0); PG8_MMA(0, 0, At, B0); PG8_BAR; PG8_SCHED;
            PG8_LDB(B1, 0, 1); PG8_STAGE(PG8_SB(0, 0), b2, voffB);
            PG8_BAR; PG8_WAIT_L(0); PG8_MMA(0, 1, At, B1); PG8_BAR;
            PG8_LDA(At, 0, 1); PG8_STAGE(PG8_SA(0, 0), a2, voffA);
            PG8_BAR; PG8_WAIT_L(0); PG8_MMA(1, 0, At, B0); PG8_BAR; PG8_SCHED;
            PG8_STAGE(PG8_SB(0, 1), b2 + hstep, voffB);
            PG8_WAIT_V(6); PG8_BAR; PG8_MMA(1, 1, At, B1); PG8_BAR;
            PG8_LDB(B0, 1, 0); PG8_SCHED; PG8_LDA(At, 1, 0); PG8_STAGE(PG8_SA(0, 1), a2 + hstep, voffA);
            PG8_WAIT_L(8); PG8_BAR; PG8_WAIT_L(0); PG8_MMA(0, 0, At, B0); PG8_BAR; PG8_SCHED;
            PG8_LDB(B1, 1, 1); PG8_STAGE(PG8_SB(1, 0), b3, voffB);
            PG8_BAR; PG8_WAIT_L(0); PG8_MMA(0, 1, At, B1); PG8_BAR;
            PG8_LDA(At, 1, 1); PG8_STAGE(PG8_SA(1, 0), a3, voffA);
            PG8_BAR; PG8_WAIT_L(0); PG8_MMA(1, 0, At, B0); PG8_BAR; PG8_SCHED;
            PG8_STAGE(PG8_SB(1, 1), b3 + hstep, voffB);
            PG8_WAIT_V(6); PG8_BAR; PG8_MMA(1, 1, At, B1); PG8_BAR;
            }
        }
        if constexpr (ALIGN_EPI) { if (wr == 0) PG8_BAR; }
        if constexpr (!Epi::AFTER_DRAIN) { E(acc, cur, wr, wc, fr, fq); S.done(cur); }
        if (!has_next) break;
#pragma unroll
        for (int a = 0; a < 2; ++a)
#pragma unroll
            for (int b = 0; b < 2; ++b)
#pragma unroll
                for (int m = 0; m < 4; ++m)
#pragma unroll
                    for (int n = 0; n < 2; ++n) acc[a][b][m][n] = (f32x4){0.f, 0.f, 0.f, 0.f};
        cur = nxt; cA = nA; cB = nB; ++ui;
        if constexpr (ALIGN_EPI) { if (wr == 1) PG8_BAR; }
    }
    PG8_WAIT_V(0);
    if constexpr (!ALIGN_EPI) { if (wr == 0) PG8_BAR; }
    PG8_BAR;
    if constexpr (Epi::AFTER_DRAIN) { E.fused(acc, cur, wr, wc, fr, fq, lds, wid, lane); S.done(cur); }
#undef PG8_SA
#undef PG8_SB
#undef PG8_STAGE
#undef PG8_LDA
#undef PG8_LDB
#undef PG8_MMA
#undef PG8_WAIT_V
#undef PG8_WAIT_L
#undef PG8_BAR
#undef PG8_SCHED
}
}
#define GAS __attribute__((address_space(1)))
#define LAS __attribute__((address_space(3)))
typedef unsigned short bf16;
typedef unsigned v4u __attribute__((ext_vector_type(4)));
typedef float f32x4 __attribute__((ext_vector_type(4)));
typedef short bf16x8 __attribute__((ext_vector_type(8)));
typedef GAS unsigned gu32;
typedef GAS unsigned long long gu64;
#define RLX_AGENT __ATOMIC_RELAXED, __HIP_MEMORY_SCOPE_AGENT
#define LDS_WAIT() asm volatile("s_waitcnt lgkmcnt(0)" ::: "memory")
#define VM_WAIT() asm volatile("s_waitcnt vmcnt(0)" ::: "memory")
__device__ __forceinline__ unsigned long long rt() { return __builtin_amdgcn_s_memrealtime(); }
__device__ __forceinline__ unsigned f2bf(float f) { unsigned u = __builtin_bit_cast(unsigned, f); return (u + 0x7fffu + ((u >> 16) & 1u)) >> 16; }
__device__ __forceinline__ unsigned pk2(float lo, float hi) { return f2bf(lo) | (f2bf(hi) << 16); }

#define XB_TMO      128
#define XB_XCNT(j)  (256  + 64 * (j))
#define XB_XSUB(j)  (1280 + 64 * (j))
#define XB_XGEN(j)  (2304 + 64 * (j))
#define XB_TOP      3328
#define XB_TOPGEN   3392
#define XCD_BAR_WORDS 3456
#define XB_SPIN_CAP (1u << 18)

__device__ __forceinline__ unsigned xb_ld(unsigned* p)              { return __hip_atomic_load(p, __ATOMIC_RELAXED, __HIP_MEMORY_SCOPE_AGENT); }
__device__ __forceinline__ unsigned xb_add(unsigned* p, unsigned v) { return __hip_atomic_fetch_add(p, v, __ATOMIC_RELAXED, __HIP_MEMORY_SCOPE_AGENT); }
__device__ __forceinline__ unsigned xb_xcc_id() { return (unsigned)__builtin_amdgcn_s_getreg((3 << 11) | 20) & 0xFu; }
#define XB_SPIN(cond, bar) do { unsigned _sp = 0; while (cond) { __builtin_amdgcn_s_sleep(1); \
    if ((++_sp & 255u) == 0u) { if (xb_ld(&(bar)[XB_TMO])) break; if (_sp > XB_SPIN_CAP) { atomicAdd(&(bar)[XB_TMO], 1u); break; } } } } while (0)

struct XcdBarrier {
    unsigned* bar; unsigned x;
    volatile LAS unsigned* st;
};

__device__ __forceinline__ XcdBarrier xcd_barrier_post(unsigned* bar, volatile LAS unsigned* st) {
    XcdBarrier b; b.bar = bar; b.x = xb_xcc_id(); b.st = st;
    if (threadIdx.x == 0) (void)xb_add(&bar[XB_XCNT(b.x)], 1u);
    return b;
}
__device__ __forceinline__ void xcd_barrier_complete(unsigned* bar, unsigned x, unsigned& nloc, unsigned& nx) {
    const unsigned G = gridDim.x * gridDim.y * gridDim.z;
    unsigned sum, cnt, mine, sp = 0u;
    for (;;) {
        sum = 0u; cnt = 0u; mine = 0u;
#pragma unroll
        for (unsigned j = 0; j < 16; ++j) { const unsigned c = xb_ld(&bar[XB_XCNT(j)]); sum += c; cnt += (c > 0u) ? 1u : 0u; mine = (j == x) ? c : mine; }
        if (sum == G) break;
        __builtin_amdgcn_s_sleep(1);
        if ((++sp & 255u) == 0u) { if (xb_ld(&bar[XB_TMO])) break; if (sp > XB_SPIN_CAP) { atomicAdd(&bar[XB_TMO], 1u); break; } }
    }
    nloc = mine > 0u ? mine : 1u; nx = cnt > 0u ? cnt : 1u;
}

__device__ __forceinline__ void xcd_barrier(const XcdBarrier& b) {
    asm volatile("s_waitcnt vmcnt(0)" ::: "memory");
    __syncthreads();
    if (threadIdx.x == 0) {
        unsigned* bar = b.bar;
        __builtin_amdgcn_s_waitcnt(0);
        unsigned nloc = b.st[0], nx = b.st[1];
        if (nloc == 0u) { xcd_barrier_complete(bar, b.x, nloc, nx); b.st[0] = nloc; b.st[1] = nx; }
        const unsigned old = xb_add(&bar[XB_XSUB(b.x)], 1u);
        const unsigned gen = old / nloc;
        if (old + 1u == (gen + 1u) * nloc) {
            __builtin_amdgcn_fence(__ATOMIC_RELEASE, "agent");
            asm volatile("s_waitcnt vmcnt(0)" ::: "memory");
            const unsigned og = xb_add(&bar[XB_TOP], 1u);
            const unsigned tg = og / nx;
            if (og + 1u == (tg + 1u) * nx) xb_add(&bar[XB_TOPGEN], 1u);
            else XB_SPIN(xb_ld(&bar[XB_TOPGEN]) == tg, bar);
            __builtin_amdgcn_fence(__ATOMIC_ACQUIRE, "agent");
            xb_add(&bar[XB_XGEN(b.x)], 1u);
            asm volatile("s_waitcnt vmcnt(0)" ::: "memory");
        } else {
            XB_SPIN(xb_ld(&bar[XB_XGEN(b.x)]) == gen, bar);
            __builtin_amdgcn_fence(__ATOMIC_ACQUIRE, "agent");
            asm volatile("s_waitcnt vmcnt(0)" ::: "memory");
        }
    }
    __syncthreads();
}

constexpr int DM = 1024, SEQ = 8192, PB = 4, SB = 128, ST = 4, LBUF = 2048;
constexpr int NP = PB * SEQ;
constexpr int NS = SB * ST;
constexpr int MT = NP + NS;
constexpr int DIN = 4104, NPROJ = 4096;
constexpr int CONVCH = 1536;
constexpr int PC_ZA = 1536, PC_QB = 2048, PC_KB = 2560, PC_VB = 3072, PC_ZB = 3584;
constexpr float NORM_EPS = 1e-6f;
constexpr size_t O_YP = 0, O_YS = (size_t)NP * DM, O_CONVP = O_YS + (size_t)NS * DM, O_DELTAP = O_CONVP + (size_t)PB * 3 * CONVCH,
                 O_KWP = O_DELTAP + (size_t)PB * 4 * 128 * 128, O_VWP = O_KWP + (size_t)PB * LBUF * 512, O_CONVS = O_VWP + (size_t)PB * LBUF * 512,
                 O_DELTAS = O_CONVS + (size_t)SB * 3 * CONVCH, O_KWS = O_DELTAS + (size_t)SB * 4 * 128 * 128, O_VWS = O_KWS + (size_t)SB * LBUF * 512,
                 O_END = O_VWS + (size_t)SB * LBUF * 512;
constexpr size_t MiB = 1u << 20;
constexpr size_t WS_CTL = 0, CTL_ZERO_BYTES = 1 * MiB;
constexpr size_t WS_WIN = 2 * MiB, WS_WOUT = 10 * MiB, WS_GB = 12 * MiB, WS_XN = 16 * MiB, WS_PROJ = 96 * MiB, WS_OA = 360 * MiB, WS_MIX = 432 * MiB, WS_CHK = 512 * MiB, WS_UT = 624 * MiB, WS_GL = 656 * MiB, WS_END = 657 * MiB;
constexpr int CW_TMO = 0, CW_Q0 = 64, CW_BAR = 4096;
constexpr int LDS_BYTES = 147456, MISC_OFF = LDS_BYTES - 256;
constexpr int NWAVES = 8, NTHR = 512;

struct Args { const float* in[14]; float* out; unsigned char* ws; int ph_lo, ph_hi; };
enum { I_XP = 0, I_XS, I_SCONV, I_SDELTA, I_CK, I_CV, I_NORMG, I_FNORMG, I_WIN, I_CONVW, I_ALOG, I_DTB, I_DNG, I_WOUT };

struct Frame {
    LAS unsigned char* lds;
    int tid, lane, wave, G;
    const float* in[14]; float* out; unsigned char* ws;
    bf16 *WinT, *WoutT, *XN, *PROJ, *MIX; float *GB, *OA;
};

__device__ __forceinline__ float wave_sum(float v) {
#pragma unroll
    for (int o = 1; o < 64; o <<= 1) v += __shfl_xor(v, o);
    return v;
}
__device__ __forceinline__ float bf2f(bf16 v) { return __uint_as_float((unsigned)v << 16); }
__device__ __forceinline__ float bflo(unsigned w) { return __uint_as_float(w << 16); }
__device__ __forceinline__ float bfhi(unsigned w) { return __uint_as_float(w & 0xffff0000u); }
__device__ __forceinline__ float siluf(float y) { return y / (1.f + __expf(-y)); }

__device__ __forceinline__ void p0_transpose_item(const float* W, int K, int ldw, int c0, bf16* WT, int n0, int k0, LAS float* scr, int lane) {
#pragma unroll 8
    for (int i = 0; i < 32; ++i) { const int kk = 2 * i + (lane >> 5); scr[kk * 33 + (lane & 31)] = W[(size_t)(k0 + kk) * ldw + c0 + (lane & 31)]; }
    LDS_WAIT(); asm volatile("" ::: "memory");
    const int c = lane & 7;
#pragma unroll
    for (int j = 0; j < 4; ++j) { const int n = (lane >> 3) + 8 * j; const LAS float* s = scr + (8 * c) * 33 + n;
        v4u o; o.x = pk2(s[0 * 33], s[1 * 33]); o.y = pk2(s[2 * 33], s[3 * 33]); o.z = pk2(s[4 * 33], s[5 * 33]); o.w = pk2(s[6 * 33], s[7 * 33]);
        *(GAS v4u*)(WT + (size_t)(n0 + n) * K + k0 + 8 * c) = o; }
    LDS_WAIT(); asm volatile("" ::: "memory");
}
__device__ __forceinline__ void p0_prologue(Frame& F) {
    LAS float* W8T = (LAS float*)(F.lds);
    const float* w_in = F.in[I_WIN];
    for (int i = F.tid; i < 8 * 1024; i += NTHR) { const int k = i >> 3, e = i & 7; W8T[e * 1024 + k] = w_in[(size_t)k * DIN + 2048 + e]; }
    __syncthreads();
    const int gw = blockIdx.x * NWAVES + F.wave, NGW = F.G * NWAVES;
    const float* ng = F.in[I_NORMG];
    f32x4 gv[4];
#pragma unroll
    for (int j = 0; j < 4; ++j) gv[j] = *(const f32x4*)(ng + 4 * F.lane + 256 * j);
    const float a_log_l = (F.lane < 4) ? F.in[I_ALOG][F.lane] : 0.f, dtb_l = (F.lane < 4) ? F.in[I_DTB][F.lane] : 0.f;
    for (int m = gw; m < MT; m += NGW) {
        const float* xrow = (m < NP) ? F.in[I_XP] + (size_t)m * DM : F.in[I_XS] + (size_t)(m - NP) * DM;
        const GAS f32x4* xr = (const GAS f32x4*)xrow + F.lane;
        f32x4 v[4]; float s = 0.f;
#pragma unroll
        for (int j = 0; j < 4; ++j) { v[j] = xr[64 * j]; s += (v[j].x * v[j].x + v[j].y * v[j].y) + (v[j].z * v[j].z + v[j].w * v[j].w); }
        const float rs = 1.f / sqrtf(wave_sum(s) * (1.f / DM) + NORM_EPS);
#pragma unroll
        for (int j = 0; j < 4; ++j) v[j] = v[j] * rs * gv[j];
        GAS unsigned long long* o8 = (GAS unsigned long long*)(F.XN + (size_t)m * DM) + F.lane;
#pragma unroll
        for (int j = 0; j < 4; ++j) o8[64 * j] = (unsigned long long)pk2(v[j].x, v[j].y) | ((unsigned long long)pk2(v[j].z, v[j].w) << 32);
        float d[8];
#pragma unroll
        for (int e = 0; e < 8; ++e) { float acc = 0.f;
#pragma unroll
            for (int j = 0; j < 4; ++j) { const f32x4 w = *(const LAS f32x4*)(W8T + e * 1024 + 4 * F.lane + 256 * j); acc += (v[j].x * w.x + v[j].y * w.y) + (v[j].z * w.z + v[j].w * w.w); }
            d[e] = wave_sum(acc); }
        float mine = 0.f;
#pragma unroll
        for (int e = 0; e < 8; ++e) mine = (F.lane == e) ? d[e] : mine;
        if (F.lane < 4) { const float xx = mine + dtb_l; const float sp = xx > 20.f ? xx : log1pf(expf(xx)); F.GB[(size_t)m * 8 + F.lane] = -expf(a_log_l) * sp; }
        else if (F.lane < 8) { F.GB[(size_t)m * 8 + F.lane] = 1.f / (1.f + expf(-mine)); }
    }
    __syncthreads();
    LAS float* scr = (LAS float*)(F.lds + 32768 + F.wave * 8448);
    constexpr int I_IN = (DM / 64) * (NPROJ / 32), I_OUT = (DM / 64) * (DM / 32);
    for (int it = gw; it < I_IN + I_OUT; it += NGW) {
        if (it < I_IN) { const int kb = it / (NPROJ / 32), nb = it % (NPROJ / 32), n0 = nb * 32; p0_transpose_item(w_in, DM, DIN, n0 + (n0 >= 2048 ? 8 : 0), F.WinT, n0, kb * 64, scr, F.lane); }
        else { const int r = it - I_IN, kb = r / (DM / 32), nb = r % (DM / 32); p0_transpose_item(F.in[I_WOUT], DM, DM, nb * 32, F.WoutT, nb * 32, kb * 64, scr, F.lane); }
    }
}

__device__ __forceinline__ void dn_seq_unit(Frame& F, int unit) {
    LAS float* cv = (LAS float*)F.lds;
    LAS float* part = cv + 384;
    LAS float* psum = cv + 512;
    LAS float* osum = cv + 1024;
    const int t = F.tid, dv = t & 127, qd = t >> 7;
    int L, row0, h; const float* prefix; const float* S0; float* Sout;
    if (unit < 16) { const int b = unit >> 2; h = unit & 3; L = SEQ; row0 = b * SEQ; prefix = nullptr; S0 = nullptr; Sout = F.out + O_DELTAP + (size_t)unit * 16384; }
    else { const int u = unit - 16, b = u >> 2; h = u & 3; L = ST; row0 = NP + b * ST; prefix = F.in[I_SCONV] + (size_t)b * 3 * CONVCH; S0 = F.in[I_SDELTA] + (size_t)u * 16384; Sout = F.out + O_DELTAS + (size_t)u * 16384; }
    float S[32];
#pragma unroll
    for (int i = 0; i < 32; ++i) S[i] = S0 ? S0[(size_t)(qd * 32 + i) * 128 + dv] : 0.f;
    const int which = t >> 7, ch = t & 127, gcol = (which < 3 ? which : 0) * 512 + h * 128 + ch;
    float w0 = 0.f, w1 = 0.f, w2 = 0.f, w3 = 0.f, x0 = 0.f, x1 = 0.f, x2 = 0.f;
    if (t < 384) { const float* cw = F.in[I_CONVW]; w0 = cw[gcol]; w1 = cw[CONVCH + gcol]; w2 = cw[2 * CONVCH + gcol]; w3 = cw[3 * CONVCH + gcol];
        if (prefix) { x0 = prefix[gcol]; x1 = prefix[CONVCH + gcol]; x2 = prefix[2 * CONVCH + gcol]; } }
    __syncthreads();
    for (int tau = 0; tau < L; ++tau) {
        const size_t row = (size_t)(row0 + tau);
        float ss = 0.f;
        if (t < 384) { const float x3 = bf2f(F.PROJ[row * NPROJ + gcol]); float y = w0 * x0 + w1 * x1 + w2 * x2 + w3 * x3; x0 = x1; x1 = x2; x2 = x3; y = siluf(y); cv[t] = y; ss = (t < 256) ? y * y : 0.f; }
        if (F.wave < 4) { ss = wave_sum(ss); if (F.lane == 0) part[F.wave] = ss; }
        __syncthreads();
        const float qn = (1.f / sqrtf(part[0] + part[1] + NORM_EPS)) * 0.08838834764831845f, kn = 1.f / sqrtf(part[2] + part[3] + NORM_EPS);
        const float g = F.GB[row * 8 + h], beta = F.GB[row * 8 + 4 + h], a = expf(g);
        float p = 0.f;
#pragma unroll
        for (int i = 0; i < 32; ++i) { S[i] *= a; p += S[i] * cv[128 + qd * 32 + i]; }
        psum[qd * 128 + dv] = p * kn;
        __syncthreads();
        const float ptot = (psum[dv] + psum[128 + dv]) + (psum[256 + dv] + psum[384 + dv]);
        const float r = beta * (cv[256 + dv] - ptot);
        float o = 0.f;
#pragma unroll
        for (int i = 0; i < 32; ++i) { S[i] += (cv[128 + qd * 32 + i] * kn) * r; o += S[i] * cv[qd * 32 + i]; }
        osum[qd * 128 + dv] = o * qn;
        __syncthreads();
        if (qd == 0) F.OA[row * 512 + h * 128 + dv] = (osum[dv] + osum[128 + dv]) + (osum[256 + dv] + osum[384 + dv]);
    }
#pragma unroll
    for (int i = 0; i < 32; ++i) Sout[(size_t)(qd * 32 + i) * 128 + dv] = S[i];
    __syncthreads();
}

__device__ __forceinline__ void ld_bf16x64(const bf16* p, float (&v)[64]) {
    const v4u* p4 = (const v4u*)p;
#pragma unroll
    for (int i = 0; i < 8; ++i) { const v4u w = p4[i]; v[8 * i] = bflo(w.x); v[8 * i + 1] = bfhi(w.x); v[8 * i + 2] = bflo(w.y); v[8 * i + 3] = bfhi(w.y); v[8 * i + 4] = bflo(w.z); v[8 * i + 5] = bfhi(w.z); v[8 * i + 6] = bflo(w.w); v[8 * i + 7] = bfhi(w.w); }
}
__device__ __forceinline__ float dot_bf16row(const bf16* p, const float (&q)[64]) {
    const v4u* p4 = (const v4u*)p; float s = 0.f;
#pragma unroll
    for (int i = 0; i < 8; ++i) { const v4u w = p4[i]; s += q[8 * i] * bflo(w.x) + q[8 * i + 1] * bfhi(w.x) + q[8 * i + 2] * bflo(w.y) + q[8 * i + 3] * bfhi(w.y) + q[8 * i + 4] * bflo(w.z) + q[8 * i + 5] * bfhi(w.z) + q[8 * i + 6] * bflo(w.w) + q[8 * i + 7] * bfhi(w.w); }
    return s;
}
__device__ __forceinline__ void axpy_bf16row(const bf16* p, float a, float sc, float (&o)[64]) {
    const v4u* p4 = (const v4u*)p;
#pragma unroll
    for (int i = 0; i < 8; ++i) { const v4u w = p4[i];
        o[8 * i] = o[8 * i] * sc + a * bflo(w.x); o[8 * i + 1] = o[8 * i + 1] * sc + a * bfhi(w.x); o[8 * i + 2] = o[8 * i + 2] * sc + a * bflo(w.y); o[8 * i + 3] = o[8 * i + 3] * sc + a * bfhi(w.y);
        o[8 * i + 4] = o[8 * i + 4] * sc + a * bflo(w.z); o[8 * i + 5] = o[8 * i + 5] * sc + a * bfhi(w.z); o[8 * i + 6] = o[8 * i + 6] * sc + a * bflo(w.w); o[8 * i + 7] = o[8 * i + 7] * sc + a * bfhi(w.w); }
}
__device__ __forceinline__ float dot_f32row(const float* p, const float (&q)[64]) {
    const f32x4* p4 = (const f32x4*)p; float s = 0.f;
#pragma unroll
    for (int i = 0; i < 16; ++i) { const f32x4 w = p4[i]; s += q[4 * i] * w.x + q[4 * i + 1] * w.y + q[4 * i + 2] * w.z + q[4 * i + 3] * w.w; }
    return s;
}
__device__ __forceinline__ void axpy_f32row(const float* p, float a, float sc, float (&o)[64]) {
    const f32x4* p4 = (const f32x4*)p;
#pragma unroll
    for (int i = 0; i < 16; ++i) { const f32x4 w = p4[i]; o[4 * i] = o[4 * i] * sc + a * w.x; o[4 * i + 1] = o[4 * i + 1] * sc + a * w.y; o[4 * i + 2] = o[4 * i + 2] * sc + a * w.z; o[4 * i + 3] = o[4 * i + 3] * sc + a * w.w; }
}
__device__ __forceinline__ void attn_write(Frame& F, size_t row, int h, const float (&o)[64], float l) {
    float z[64]; ld_bf16x64(F.PROJ + row * NPROJ + PC_ZB + h * 64, z);
    const float il = 1.f / l;
    v4u* dst = (v4u*)(F.MIX + row * DM + 512 + h * 64);
#pragma unroll
    for (int i = 0; i < 8; ++i) { v4u w; w.x = pk2(o[8 * i] * il * siluf(z[8 * i]), o[8 * i + 1] * il * siluf(z[8 * i + 1])); w.y = pk2(o[8 * i + 2] * il * siluf(z[8 * i + 2]), o[8 * i + 3] * il * siluf(z[8 * i + 3]));
        w.z = pk2(o[8 * i + 4] * il * siluf(z[8 * i + 4]), o[8 * i + 5] * il * siluf(z[8 * i + 5])); w.w = pk2(o[8 * i + 6] * il * siluf(z[8 * i + 6]), o[8 * i + 7] * il * siluf(z[8 * i + 7])); dst[i] = w; }
}
__device__ __forceinline__ void attn_simple(Frame& F) {
    const int gt = blockIdx.x * NTHR + F.tid, NGT = F.G * NTHR;
    for (int it = gt; it < PB * 8 * SEQ; it += NGT) {
        const int bh = it >> 13, pos = it & (SEQ - 1), b = bh >> 3, h = bh & 7; const size_t row = (size_t)b * SEQ + pos;
        float q[64]; ld_bf16x64(F.PROJ + row * NPROJ + PC_QB + h * 64, q);
#pragma unroll
        for (int i = 0; i < 64; ++i) q[i] *= 0.125f;
        float o[64];
#pragma unroll
        for (int i = 0; i < 64; ++i) o[i] = 0.f;
        float m = -INFINITY, l = 0.f;
        for (int br = 0; br < 3; ++br) { const int d = br == 0 ? 1 : (br == 1 ? 4 : 16);
            for (int j = 0; j <= 128; ++j) { const int kp = pos - d * j; if (kp < 0) break;
                const bf16* kr = F.PROJ + ((size_t)b * SEQ + kp) * NPROJ + h * 64;
                const float s = dot_bf16row(kr + PC_KB, q); const float mn = fmaxf(m, s), sc = __expf(m - mn), p = __expf(s - mn);
                l = l * sc + p; axpy_bf16row(kr + PC_VB, p, sc, o); m = mn; } }
        attn_write(F, row, h, o, l);
    }
    for (int it = gt; it < SB * 8 * ST; it += NGT) {
        const int t = it & 3, bh = it >> 2, b = bh >> 3, h = bh & 7; const size_t row = (size_t)NP + b * ST + t;
        float q[64]; ld_bf16x64(F.PROJ + row * NPROJ + PC_QB + h * 64, q);
#pragma unroll
        for (int i = 0; i < 64; ++i) q[i] *= 0.125f;
        float o[64];
#pragma unroll
        for (int i = 0; i < 64; ++i) o[i] = 0.f;
        float m = -INFINITY, l = 0.f;
        for (int br = 0; br < 3; ++br) { const int d = br == 0 ? 1 : (br == 1 ? 4 : 16);
            for (int j = 0; j <= 128; ++j) { const int idx = LBUF + t - d * j; if (idx < 0) break;
                float s;
                if (idx >= LBUF) { const bf16* kr = F.PROJ + ((size_t)NP + b * ST + (idx - LBUF)) * NPROJ + h * 64; s = dot_bf16row(kr + PC_KB, q);
                    const float mn = fmaxf(m, s), sc = __expf(m - mn), p = __expf(s - mn); l = l * sc + p; axpy_bf16row(kr + PC_VB, p, sc, o); m = mn; }
                else { const size_t off = ((size_t)b * LBUF + idx) * 512 + h * 64; s = dot_f32row(F.in[I_CK] + off, q);
                    const float mn = fmaxf(m, s), sc = __expf(m - mn), p = __expf(s - mn); l = l * sc + p; axpy_f32row(F.in[I_CV] + off, p, sc, o); m = mn; } } }
        attn_write(F, row, h, o, l);
    }
}

__device__ __forceinline__ f32x4 ld4bf(const bf16* p) { const unsigned long long w = *(const unsigned long long*)p; return (f32x4){bflo((unsigned)w), bfhi((unsigned)w), bflo((unsigned)(w >> 32)), bfhi((unsigned)(w >> 32))}; }
__device__ __forceinline__ void copy_outputs(Frame& F) {
    const size_t gt = (size_t)blockIdx.x * NTHR + F.tid, NGT = (size_t)F.G * NTHR;
    for (size_t i = gt; i < ((size_t)2 << 25); i += NGT) {
        const int which = (int)(i >> 25); const size_t rem = i & (((size_t)1 << 25) - 1); const int b = (int)(rem >> 18), w = (int)(rem & ((1 << 18) - 1)), r = w >> 7, c4 = w & 127;
        f32x4 v;
        if (r < LBUF - ST) v = *(const f32x4*)(F.in[which ? I_CV : I_CK] + ((size_t)b * LBUF + r + ST) * 512 + c4 * 4);
        else v = ld4bf(F.PROJ + ((size_t)NP + b * ST + (r - (LBUF - ST))) * NPROJ + (which ? PC_VB : PC_KB) + c4 * 4);
        *(f32x4*)(F.out + (which ? O_VWS : O_KWS) + rem * 4) = v;
    }
    for (size_t i = gt; i < ((size_t)2 << 20); i += NGT) {
        const int which = (int)(i >> 20); const size_t rem = i & (((size_t)1 << 20) - 1); const int b = (int)(rem >> 18), w = (int)(rem & ((1 << 18) - 1)), r = w >> 7, c4 = w & 127;
        *(f32x4*)(F.out + (which ? O_VWP : O_KWP) + rem * 4) = ld4bf(F.PROJ + ((size_t)b * SEQ + (SEQ - LBUF) + r) * NPROJ + (which ? PC_VB : PC_KB) + c4 * 4);
    }
    for (size_t i = gt; i < (size_t)(PB + SB) * 3 * (CONVCH / 4); i += NGT) {
        const int c4 = (int)(i % (CONVCH / 4)), rr = (int)(i / (CONVCH / 4)), j = rr % 3, b = rr / 3;
        if (b < PB) *(f32x4*)(F.out + O_CONVP + ((size_t)b * 3 + j) * CONVCH + c4 * 4) = ld4bf(F.PROJ + ((size_t)b * SEQ + SEQ - 3 + j) * NPROJ + c4 * 4);
        else { const int bs = b - PB; *(f32x4*)(F.out + O_CONVS + ((size_t)bs * 3 + j) * CONVCH + c4 * 4) = ld4bf(F.PROJ + ((size_t)NP + bs * ST + 1 + j) * NPROJ + c4 * 4); }
    }
}

__device__ __forceinline__ void mix_a_finish(Frame& F) {
    const int gw = blockIdx.x * NWAVES + F.wave, NGW = F.G * NWAVES;
    const float g0 = F.in[I_DNG][2 * F.lane], g1 = F.in[I_DNG][2 * F.lane + 1];
    for (int it = gw; it < MT * 4; it += NGW) {
        const size_t row = (size_t)(it >> 2); const int h = it & 3;
        const float2 v = *(const float2*)(F.OA + row * 512 + h * 128 + 2 * F.lane);
        const float rs = 1.f / sqrtf(wave_sum(v.x * v.x + v.y * v.y) * (1.f / 128.f) + NORM_EPS);
        const unsigned zw = *(const unsigned*)(F.PROJ + row * NPROJ + PC_ZA + h * 128 + 2 * F.lane);
        *(unsigned*)(F.MIX + row * DM + h * 128 + 2 * F.lane) = pk2(v.x * rs * g0 * siluf(bflo(zw)), v.y * rs * g1 * siluf(bfhi(zw)));
    }
}
__device__ __forceinline__ void final_norm(Frame& F) {
    const int gw = blockIdx.x * NWAVES + F.wave, NGW = F.G * NWAVES;
    f32x4 gv[4];
#pragma unroll
    for (int j = 0; j < 4; ++j) gv[j] = *(const f32x4*)(F.in[I_FNORMG] + 4 * F.lane + 256 * j);
    for (int m = gw; m < MT; m += NGW) {
        GAS f32x4* yr = (GAS f32x4*)(F.out + (size_t)m * DM) + F.lane;
        f32x4 v[4]; float s = 0.f;
#pragma unroll
        for (int j = 0; j < 4; ++j) { v[j] = yr[64 * j]; s += (v[j].x * v[j].x + v[j].y * v[j].y) + (v[j].z * v[j].z + v[j].w * v[j].w); }
        const float rs = 1.f / sqrtf(wave_sum(s) * (1.f / DM) + NORM_EPS);
#pragma unroll
        for (int j = 0; j < 4; ++j) yr[64 * j] = v[j] * rs * gv[j];
    }
}


typedef float f32x16 __attribute__((ext_vector_type(16)));
typedef float f32x2_t __attribute__((ext_vector_type(2)));
typedef __bf16 bf16x2_t __attribute__((ext_vector_type(2)));
typedef unsigned v2u __attribute__((ext_vector_type(2)));
__device__ __forceinline__ unsigned cvtpk(float lo, float hi) { f32x2_t v = {lo, hi}; bf16x2_t b = __builtin_convertvector(v, bf16x2_t); return __builtin_bit_cast(unsigned, b); }
__device__ __forceinline__ int crow(int r, int hi) { return (r & 3) + 8 * (r >> 2) + 4 * hi; }
#define MFMA32(a, b, c) __builtin_amdgcn_mfma_f32_32x32x16_bf16((a), (b), (c), 0, 0, 0)
__device__ __forceinline__ bf16x8 pack8(const f32x16& x, int s) {
    v4u p; p.x = cvtpk(x[8 * s], x[8 * s + 1]); p.y = cvtpk(x[8 * s + 2], x[8 * s + 3]); p.z = cvtpk(x[8 * s + 4], x[8 * s + 5]); p.w = cvtpk(x[8 * s + 6], x[8 * s + 7]);
    return __builtin_bit_cast(bf16x8, p);
}
constexpr int CHK_BYTES = 57344, CHK_WF = 0, CHK_QF = 16384, CHK_AF = 32768, CHK_KF = 40960;
constexpr int NCHUNK = SEQ / 64, NUNIT = PB * 4 * NCHUNK;
constexpr int CP_ROWB = 272;
constexpr int CP_QB = 0, CP_KB = 17408, CP_VB = 34816, CP_AM = 52224, CP_GC = 68608, CP_BETA = 68864, CP_EG = 69120, CP_HALF = 69632;

__device__ __forceinline__ void chunk_prep_pair(Frame& F, int pair) {
    int lane_ = F.lane; asm volatile("" : "+v"(lane_));
    const int half = F.tid >> 8, ht = F.tid & 255, hw = F.wave & 3, lane = lane_;
    const int unit = pair * 2 + half;
    const int bh = unit >> 7, c = unit & (NCHUNK - 1), b = bh >> 2, h = bh & 3;
    const int row0 = b * SEQ + c * 64;
    LAS unsigned char* L = F.lds + half * CP_HALF;
    LAS float* AM = (LAS float*)(L + CP_AM); LAS float* GC = (LAS float*)(L + CP_GC); LAS float* BETA = (LAS float*)(L + CP_BETA); LAS float* EG = (LAS float*)(L + CP_EG);
    unsigned char* chk = F.ws + WS_CHK + (size_t)unit * CHK_BYTES;
    if (hw == 0) {
        float g = F.GB[(size_t)(row0 + lane) * 8 + h]; const float be = F.GB[(size_t)(row0 + lane) * 8 + 4 + h];
#pragma unroll
        for (int o = 1; o < 64; o <<= 1) { const float t = __shfl_up(g, o); if (lane >= o) g += t; }
        GC[lane] = g; BETA[lane] = be; EG[lane] = __expf(g);
        if (lane == 63) ((float*)(F.ws + WS_GL))[unit] = __expf(g);
    }
    {
        const float* cw = F.in[I_CONVW];
        float wq[4][2], wk[4][2], wv[4][2];
#pragma unroll
        for (int j = 0; j < 4; ++j) { const float2 a = *(const float2*)(cw + j * CONVCH + h * 128 + 2 * lane), bq = *(const float2*)(cw + j * CONVCH + 512 + h * 128 + 2 * lane), cq = *(const float2*)(cw + j * CONVCH + 1024 + h * 128 + 2 * lane);
            wq[j][0] = a.x; wq[j][1] = a.y; wk[j][0] = bq.x; wk[j][1] = bq.y; wv[j][0] = cq.x; wv[j][1] = cq.y; }
        float xq[3][2], xk[3][2], xv[3][2];
        const int tok0 = c * 64 + hw * 16;
#pragma unroll
        for (int j = 0; j < 3; ++j) { const int tp = tok0 - 3 + j; unsigned a = 0u, bq = 0u, cq = 0u;
            if (tp >= 0) { const bf16* pr = F.PROJ + (size_t)(b * SEQ + tp) * NPROJ + h * 128 + 2 * lane; a = *(const unsigned*)pr; bq = *(const unsigned*)(pr + 512); cq = *(const unsigned*)(pr + 1024); }
            xq[j][0] = bflo(a); xq[j][1] = bfhi(a); xk[j][0] = bflo(bq); xk[j][1] = bfhi(bq); xv[j][0] = bflo(cq); xv[j][1] = bfhi(cq); }
#pragma unroll 4
        for (int tt = 0; tt < 16; ++tt) {
            const int tl = hw * 16 + tt;
            const bf16* pr = F.PROJ + (size_t)(row0 + tl) * NPROJ + h * 128 + 2 * lane;
            const unsigned a = *(const unsigned*)pr, bq = *(const unsigned*)(pr + 512), cq = *(const unsigned*)(pr + 1024);
            const float nq0 = bflo(a), nq1 = bfhi(a), nk0 = bflo(bq), nk1 = bfhi(bq), nv0 = bflo(cq), nv1 = bfhi(cq);
            float yq0 = wq[0][0] * xq[0][0] + wq[1][0] * xq[1][0] + wq[2][0] * xq[2][0] + wq[3][0] * nq0, yq1 = wq[0][1] * xq[0][1] + wq[1][1] * xq[1][1] + wq[2][1] * xq[2][1] + wq[3][1] * nq1;
            float yk0 = wk[0][0] * xk[0][0] + wk[1][0] * xk[1][0] + wk[2][0] * xk[2][0] + wk[3][0] * nk0, yk1 = wk[0][1] * xk[0][1] + wk[1][1] * xk[1][1] + wk[2][1] * xk[2][1] + wk[3][1] * nk1;
            float yv0 = wv[0][0] * xv[0][0] + wv[1][0] * xv[1][0] + wv[2][0] * xv[2][0] + wv[3][0] * nv0, yv1 = wv[0][1] * xv[0][1] + wv[1][1] * xv[1][1] + wv[2][1] * xv[2][1] + wv[3][1] * nv1;
#pragma unroll
            for (int e = 0; e < 2; ++e) { xq[0][e] = xq[1][e]; xq[1][e] = xq[2][e]; xk[0][e] = xk[1][e]; xk[1][e] = xk[2][e]; xv[0][e] = xv[1][e]; xv[1][e] = xv[2][e]; }
            xq[2][0] = nq0; xq[2][1] = nq1; xk[2][0] = nk0; xk[2][1] = nk1; xv[2][0] = nv0; xv[2][1] = nv1;
            yq0 = siluf(yq0); yq1 = siluf(yq1); yk0 = siluf(yk0); yk1 = siluf(yk1); yv0 = siluf(yv0); yv1 = siluf(yv1);
            const float qn = (1.f / sqrtf(wave_sum(yq0 * yq0 + yq1 * yq1) + NORM_EPS)) * 0.08838834764831845f, kn = 1.f / sqrtf(wave_sum(yk0 * yk0 + yk1 * yk1) + NORM_EPS);
            *(LAS unsigned*)(L + CP_QB + tl * CP_ROWB + 4 * lane) = cvtpk(yq0 * qn, yq1 * qn);
            *(LAS unsigned*)(L + CP_KB + tl * CP_ROWB + 4 * lane) = cvtpk(yk0 * kn, yk1 * kn);
            *(LAS unsigned*)(L + CP_VB + tl * CP_ROWB + 4 * lane) = cvtpk(yv0, yv1);
        }
    }
    __syncthreads();
    {
        const int r = lane & 31, hh = lane >> 5;
        f32x16 zero; for (int i = 0; i < 16; ++i) zero[i] = 0.f;
        const int njobs = 2;
#pragma unroll
        for (int job = 0; job < njobs; ++job) {
            int ta, tb; bool isz = false;
            if (hw == 0 || hw == 2) { ta = job; tb = job; } else if (hw == 1) { ta = job == 0 ? 1 : 0; tb = job == 0 ? 0 : 1; isz = job == 1; } else { ta = job == 0 ? 0 : 1; tb = job == 0 ? 1 : 0; isz = job == 1; }
            f32x16 acc = zero;
            if (!isz) {
                const int srcB = (hw < 2) ? CP_KB : CP_QB;
#pragma unroll
                for (int ks = 0; ks < 8; ++ks) {
                    const bf16x8 fa = *(const LAS bf16x8*)(L + CP_KB + (32 * ta + r) * CP_ROWB + (16 * ks + 8 * hh) * 2);
                    const bf16x8 fb = *(const LAS bf16x8*)(L + srcB + (32 * tb + r) * CP_ROWB + (16 * ks + 8 * hh) * 2);
                    acc = MFMA32(fa, fb, acc);
                }
            }
            if (hw < 2) {
                const int j = 32 * tb + r; const float gj = GC[j];
#pragma unroll
                for (int q = 0; q < 16; ++q) { const int i = 32 * ta + crow(q, hh); const float v = (i > j) ? acc[q] * BETA[i] * __expf(GC[i] - gj) : 0.f; AM[i * 64 + j] = v; }
            } else {
                const int i = 32 * tb + r; const float gi = GC[i];
                f32x16 x;
#pragma unroll
                for (int q = 0; q < 16; ++q) { const int j = 32 * ta + crow(q, hh); x[q] = (i >= j) ? acc[q] * __expf(gi - GC[j]) : 0.f; }
#pragma unroll
                for (int s = 0; s < 2; ++s) *(bf16x8*)(chk + CHK_AF + ((tb * 4 + 2 * ta + s) * 64 + lane) * 16) = pack8(x, s);
            }
        }
    }
    {
        const float gl_last = GC[63];
#pragma unroll
        for (int rep = 0; rep < 4; ++rep) {
            const int item = rep * 256 + ht, fl = item & 63, fr = item >> 6, m = fr >> 3, ks = fr & 7, r = fl & 31, hh = fl >> 5;
            const int i = 32 * m + r, col = 32 * (ks >> 1) + 16 * (ks & 1) + 4 * hh; const float e = EG[i];
            const v2u lo = *(const LAS v2u*)(L + CP_QB + i * CP_ROWB + col * 2), hi = *(const LAS v2u*)(L + CP_QB + i * CP_ROWB + (col + 8) * 2);
            v4u o; o.x = cvtpk(bflo(lo.x) * e, bfhi(lo.x) * e); o.y = cvtpk(bflo(lo.y) * e, bfhi(lo.y) * e); o.z = cvtpk(bflo(hi.x) * e, bfhi(hi.x) * e); o.w = cvtpk(bflo(hi.y) * e, bfhi(hi.y) * e);
            *(v4u*)(chk + CHK_QF + (size_t)item * 16) = o;
        }
#pragma unroll
        for (int rep = 0; rep < 4; ++rep) {
            const int item = rep * 256 + ht, fl = item & 63, fr = item >> 6, mt = fr >> 2, ks = fr & 3, r = fl & 31, hh = fl >> 5;
            const int dk = 32 * mt + r, j0 = 32 * (ks >> 1) + 16 * (ks & 1) + 4 * hh;
            float v[8];
#pragma unroll
            for (int jj = 0; jj < 8; ++jj) { const int j = j0 + 8 * (jj >> 2) + (jj & 3); v[jj] = bf2f(*(const LAS bf16*)(L + CP_KB + j * CP_ROWB + dk * 2)) * __expf(gl_last - GC[j]); }
            v4u o; o.x = cvtpk(v[0], v[1]); o.y = cvtpk(v[2], v[3]); o.z = cvtpk(v[4], v[5]); o.w = cvtpk(v[6], v[7]);
            *(v4u*)(chk + CHK_KF + (size_t)item * 16) = o;
        }
    }
    float x[64];
    {
        const int cc = ht & 127; const int src = (ht < 128) ? CP_VB : CP_KB;
#pragma unroll
        for (int i = 0; i < 64; ++i) { const float sc = (ht < 128) ? BETA[i] : BETA[i] * EG[i]; x[i] = bf2f(*(const LAS bf16*)(L + src + i * CP_ROWB + cc * 2)) * sc; }
    }
    __syncthreads();
#pragma unroll
    for (int i = 1; i < 64; ++i) {
        float acc0 = 0.f, acc1 = 0.f;
#pragma unroll
        for (int j4 = 0; j4 < (i + 3) / 4; ++j4) {
            const f32x4 a = *(const LAS f32x4*)(AM + i * 64 + 4 * j4);
            acc0 += a.x * x[4 * j4] + a.z * x[4 * j4 + 2]; acc1 += a.y * x[4 * j4 + 1] + a.w * x[4 * j4 + 3];
        }
        x[i] -= acc0 + acc1;
    }
    if (ht < 128) {
        v4u* dst = (v4u*)(F.ws + WS_UT + ((size_t)unit * 128 + ht) * 128);
#pragma unroll
        for (int mh = 0; mh < 4; ++mh) { const int m = mh >> 1, hh = mh & 1;
#pragma unroll
            for (int p = 0; p < 2; ++p) { v4u o;
                o.x = cvtpk(x[32 * m + crow(8 * p + 0, hh)], x[32 * m + crow(8 * p + 1, hh)]); o.y = cvtpk(x[32 * m + crow(8 * p + 2, hh)], x[32 * m + crow(8 * p + 3, hh)]);
                o.z = cvtpk(x[32 * m + crow(8 * p + 4, hh)], x[32 * m + crow(8 * p + 5, hh)]); o.w = cvtpk(x[32 * m + crow(8 * p + 6, hh)], x[32 * m + crow(8 * p + 7, hh)]);
                dst[mh * 2 + p] = o; } }
    } else {
        const int cc = ht - 128;
#pragma unroll
        for (int i = 0; i < 64; ++i) *(LAS bf16*)(L + CP_QB + i * CP_ROWB + cc * 2) = (bf16)(cvtpk(x[i], 0.f) & 0xffffu);
    }
    __syncthreads();
#pragma unroll
    for (int rep = 0; rep < 4; ++rep) {
        const int item = rep * 256 + ht, fl = item & 63, fr = item >> 6, m = fr >> 3, ks = fr & 7, r = fl & 31, hh = fl >> 5;
        const int i = 32 * m + r, col = 32 * (ks >> 1) + 16 * (ks & 1) + 4 * hh;
        const v2u lo = *(const LAS v2u*)(L + CP_QB + i * CP_ROWB + col * 2), hi = *(const LAS v2u*)(L + CP_QB + i * CP_ROWB + (col + 8) * 2);
        v4u o; o.x = lo.x; o.y = lo.y; o.z = hi.x; o.w = hi.y;
        *(v4u*)(chk + CHK_WF + (size_t)item * 16) = o;
    }
    __syncthreads();
}

__device__ __forceinline__ void dn_scan_unit(Frame& F, int bh) {
    int lane_ = threadIdx.x & 63; asm volatile("" : "+v"(lane_));
    const int lane = lane_, wave = F.wave, r = lane & 31, hh = lane >> 5;
    const int b = bh >> 2, h = bh & 3;
    const unsigned char* chk0 = F.ws + WS_CHK + (size_t)bh * NCHUNK * CHK_BYTES;
#define SCAN_BAR() do { asm volatile("s_waitcnt lgkmcnt(0)" ::: "memory"); __builtin_amdgcn_s_barrier(); asm volatile("" ::: "memory"); } while (0)
    if (wave >= 4) {
        const int lt = F.tid - 256;
        v4u ra[14], rb[14];
#pragma unroll
        for (int i = 0; i < 14; ++i) ra[i] = *(const v4u*)(chk0 + (size_t)(i * 256 + lt) * 16);
#pragma unroll
        for (int i = 0; i < 14; ++i) rb[i] = *(const v4u*)(chk0 + CHK_BYTES + (size_t)(i * 256 + lt) * 16);
#pragma unroll
        for (int i = 0; i < 14; ++i) *(LAS v4u*)(F.lds + (i * 256 + lt) * 16) = ra[i];
        SCAN_BAR();
        for (int c = 0; c < NCHUNK; c += 2) {
#pragma unroll
            for (int i = 0; i < 14; ++i) *(LAS v4u*)(F.lds + CHK_BYTES + (i * 256 + lt) * 16) = rb[i];
            if (c + 2 < NCHUNK) {
#pragma unroll
                for (int i = 0; i < 14; ++i) ra[i] = *(const v4u*)(chk0 + (size_t)(c + 2) * CHK_BYTES + (size_t)(i * 256 + lt) * 16);
            }
            SCAN_BAR();
            if (c + 2 < NCHUNK) {
#pragma unroll
                for (int i = 0; i < 14; ++i) *(LAS v4u*)(F.lds + (i * 256 + lt) * 16) = ra[i];
            }
            if (c + 3 < NCHUNK) {
#pragma unroll
                for (int i = 0; i < 14; ++i) rb[i] = *(const v4u*)(chk0 + (size_t)(c + 3) * CHK_BYTES + (size_t)(i * 256 + lt) * 16);
            }
            SCAN_BAR();
        }
    } else {
        const int n0 = wave * 32;
        f32x16 S[4];
#pragma unroll
        for (int mt = 0; mt < 4; ++mt)
#pragma unroll
            for (int i = 0; i < 16; ++i) S[mt][i] = 0.f;
        const unsigned char* ut0 = F.ws + WS_UT + ((size_t)bh * NCHUNK * 128 + n0 + r) * 128 + hh * 32;
        const float* gl0 = (const float*)(F.ws + WS_GL) + bh * NCHUNK;
        v4u un[4];
#pragma unroll
        for (int m = 0; m < 2; ++m) { un[2 * m] = *(const v4u*)(ut0 + m * 64); un[2 * m + 1] = *(const v4u*)(ut0 + m * 64 + 16); }
        SCAN_BAR();
        for (int c = 0; c < NCHUNK; ++c) {
            LAS unsigned char* slot = F.lds + (c & 1) * CHK_BYTES;
            const float gl = gl0[c];
            f32x16 ws[2], qs[2];
#pragma unroll
            for (int m = 0; m < 2; ++m)
#pragma unroll
                for (int i = 0; i < 16; ++i) { ws[m][i] = 0.f; qs[m][i] = 0.f; }
#pragma unroll
            for (int ks = 0; ks < 8; ++ks) {
                const bf16x8 bS = pack8(S[ks >> 1], ks & 1);
#pragma unroll
                for (int m = 0; m < 2; ++m) {
                    const bf16x8 aw = *(const LAS bf16x8*)(slot + CHK_WF + ((m * 8 + ks) * 64 + lane) * 16);
                    const bf16x8 aq = *(const LAS bf16x8*)(slot + CHK_QF + ((m * 8 + ks) * 64 + lane) * 16);
                    ws[m] = MFMA32(aw, bS, ws[m]); qs[m] = MFMA32(aq, bS, qs[m]);
                }
            }
#pragma unroll
            for (int m = 0; m < 2; ++m) {
                const v4u u0 = un[2 * m], u1 = un[2 * m + 1];
                ws[m][0] = bflo(u0.x) - ws[m][0]; ws[m][1] = bfhi(u0.x) - ws[m][1]; ws[m][2] = bflo(u0.y) - ws[m][2]; ws[m][3] = bfhi(u0.y) - ws[m][3];
                ws[m][4] = bflo(u0.z) - ws[m][4]; ws[m][5] = bfhi(u0.z) - ws[m][5]; ws[m][6] = bflo(u0.w) - ws[m][6]; ws[m][7] = bfhi(u0.w) - ws[m][7];
                ws[m][8] = bflo(u1.x) - ws[m][8]; ws[m][9] = bfhi(u1.x) - ws[m][9]; ws[m][10] = bflo(u1.y) - ws[m][10]; ws[m][11] = bfhi(u1.y) - ws[m][11];
                ws[m][12] = bflo(u1.z) - ws[m][12]; ws[m][13] = bfhi(u1.z) - ws[m][13]; ws[m][14] = bflo(u1.w) - ws[m][14]; ws[m][15] = bfhi(u1.w) - ws[m][15];
            }
            if (c + 1 < NCHUNK) {
#pragma unroll
                for (int m = 0; m < 2; ++m) { un[2 * m] = *(const v4u*)(ut0 + (size_t)(c + 1) * 16384 + m * 64); un[2 * m + 1] = *(const v4u*)(ut0 + (size_t)(c + 1) * 16384 + m * 64 + 16); }
            }
            bf16x8 vb[4];
#pragma unroll
            for (int k = 0; k < 4; ++k) vb[k] = pack8(ws[k >> 1], k & 1);
#pragma unroll
            for (int k = 0; k < 4; ++k)
#pragma unroll
                for (int m = 0; m < 2; ++m) { const bf16x8 aa = *(const LAS bf16x8*)(slot + CHK_AF + ((m * 4 + k) * 64 + lane) * 16); qs[m] = MFMA32(aa, vb[k], qs[m]); }
            {
                float* orow = F.OA + (size_t)(b * SEQ + c * 64 + 4 * hh) * 512 + h * 128 + n0 + r;
                asm volatile("" : "+v"(orow));
#pragma unroll
                for (int m = 0; m < 2; ++m)
#pragma unroll
                    for (int i = 0; i < 16; ++i) orow[(32 * m + (i & 3) + 8 * (i >> 2)) * 512] = qs[m][i];
            }
#pragma unroll
            for (int mt = 0; mt < 4; ++mt) {
                S[mt] = S[mt] * gl;
#pragma unroll
                for (int k = 0; k < 4; ++k) { const bf16x8 ak = *(const LAS bf16x8*)(slot + CHK_KF + ((mt * 4 + k) * 64 + lane) * 16); S[mt] = MFMA32(ak, vb[k], S[mt]); }
            }
            SCAN_BAR();
        }
        float* so = F.out + O_DELTAP + (size_t)bh * 16384 + (4 * hh) * 128 + n0 + r;
#pragma unroll
        for (int mt = 0; mt < 4; ++mt)
#pragma unroll
            for (int i = 0; i < 16; ++i) so[(32 * mt + (i & 3) + 8 * (i >> 2)) * 128] = S[mt][i];
    }
#undef SCAN_BAR
    __syncthreads();
}


typedef short s16x4 __attribute__((ext_vector_type(4)));
typedef short v4i16_t __attribute__((ext_vector_type(4)));
__device__ __forceinline__ s16x4 vtr(const LAS unsigned char* p) { return __builtin_bit_cast(s16x4, __builtin_amdgcn_ds_read_tr16_b64_v4i16((LAS v4i16_t*)p)); }
constexpr int AT_VROW = 144, AT_VSLOT = 32 * AT_VROW, AT_WAVE_LDS = 2 * AT_VSLOT;
constexpr int AT_NTILE = 33;
constexpr float AT_C2 = 0.125f * 1.4426950408889634f;
__device__ __forceinline__ void at_tile_params(int ti, int& dsh, int& e0) {
    if (ti < 5) { dsh = 4; e0 = -128 + 32 * (4 - ti); } else if (ti < 13) { dsh = 2; e0 = -128 + 32 * (ti - 5); } else { dsh = 0; e0 = -128 + 32 * (ti - 13); }
}
__device__ __forceinline__ void attn_prompt_unit(Frame& F, int wu, LAS unsigned char* vl) {
    int lane_ = threadIdx.x & 63; asm volatile("" : "+v"(lane_));
    const int lane = lane_, r = lane & 31, hh = lane >> 5;
    const int rr = wu & 15, blk = (wu >> 4) & 15, bh = wu >> 8, b = bh >> 3, h = bh & 7;
    const int base = blk * 512 + rr, qpos = base + 16 * r;
    const bf16* Pb = F.PROJ + (size_t)b * SEQ * NPROJ + h * 64;
    bf16x8 qf[4];
#pragma unroll
    for (int ks = 0; ks < 4; ++ks) qf[ks] = *(const bf16x8*)(Pb + (size_t)qpos * NPROJ + PC_QB + 16 * ks + 8 * hh);
    f32x16 O[2];
#pragma unroll
    for (int i = 0; i < 16; ++i) { O[0][i] = 0.f; O[1][i] = 0.f; }
    float m = -INFINITY, l = 0.f;
    const int vkey = lane >> 3, vpiece = lane & 7;
    const int troff = (4 * hh + ((lane & 15) >> 2)) * AT_VROW + (16 * ((lane >> 4) & 1) + 4 * (lane & 3)) * 2;
    bf16x8 kf[4]; v4u vn[4];
    {
        int dsh, e0; at_tile_params(0, dsh, e0);
        int pk = base + ((e0 + r) << dsh); pk = pk < 0 ? 0 : (pk > SEQ - 1 ? SEQ - 1 : pk);
#pragma unroll
        for (int ks = 0; ks < 4; ++ks) kf[ks] = *(const bf16x8*)(Pb + (size_t)pk * NPROJ + PC_KB + 16 * ks + 8 * hh);
#pragma unroll
        for (int it = 0; it < 4; ++it) { int pv = base + ((e0 + vkey + 8 * it) << dsh); pv = pv < 0 ? 0 : (pv > SEQ - 1 ? SEQ - 1 : pv);
            vn[it] = *(const v4u*)(Pb + (size_t)pv * NPROJ + PC_VB + vpiece * 8); }
#pragma unroll
        for (int it = 0; it < 4; ++it) *(LAS v4u*)(vl + (vkey + 8 * it) * AT_VROW + vpiece * 16) = vn[it];
    }
    for (int ti = 0; ti < AT_NTILE; ++ti) {
        int dsh, e0; at_tile_params(ti, dsh, e0);
        bf16x8 kn[4];
        if (ti + 1 < AT_NTILE) {
            int dsh1, e01; at_tile_params(ti + 1, dsh1, e01);
            int pk = base + ((e01 + r) << dsh1); pk = pk < 0 ? 0 : (pk > SEQ - 1 ? SEQ - 1 : pk);
#pragma unroll
            for (int ks = 0; ks < 4; ++ks) kn[ks] = *(const bf16x8*)(Pb + (size_t)pk * NPROJ + PC_KB + 16 * ks + 8 * hh);
#pragma unroll
            for (int it = 0; it < 4; ++it) { int pv = base + ((e01 + vkey + 8 * it) << dsh1); pv = pv < 0 ? 0 : (pv > SEQ - 1 ? SEQ - 1 : pv);
                vn[it] = *(const v4u*)(Pb + (size_t)pv * NPROJ + PC_VB + vpiece * 8); }
        }
        f32x16 st;
#pragma unroll
        for (int i = 0; i < 16; ++i) st[i] = 0.f;
#pragma unroll
        for (int ks = 0; ks < 4; ++ks) st = MFMA32(kf[ks], qf[ks], st);
        const int X = ((16 >> dsh) * r) - e0;
        int lo = X - 128; const int emin = -(base >> dsh) - e0; lo = lo > emin ? lo : emin;
        int hi = X; lo -= 4 * hh; hi -= 4 * hh;
        if (hi < lo) { lo = 1000; hi = 1000; }
        const unsigned range = (unsigned)(hi - lo);
        float mt = -INFINITY;
#pragma unroll
        for (int i = 0; i < 16; ++i) { const int c = (i & 3) + 8 * (i >> 2); const bool ok = (unsigned)(c - lo) <= range; st[i] = ok ? st[i] * AT_C2 : -INFINITY; mt = fmaxf(mt, st[i]); }
        mt = fmaxf(mt, __shfl_xor(mt, 32));
        const float mn = fmaxf(m, mt);
        const float alpha = __builtin_amdgcn_exp2f(m - mn);
        float ps = 0.f;
#pragma unroll
        for (int i = 0; i < 16; ++i) { st[i] = __builtin_amdgcn_exp2f(st[i] - mn); ps += st[i]; }
        l = l * alpha + ps; m = mn;
        if (__any(alpha != 1.f)) {
#pragma unroll
            for (int i = 0; i < 16; ++i) { O[0][i] *= alpha; O[1][i] *= alpha; }
        }
        const LAS unsigned char* vs = vl + (ti & 1) * AT_VSLOT + troff;
#pragma unroll
        for (int s = 0; s < 2; ++s) {
            const bf16x8 pb = pack8(st, s);
#pragma unroll
            for (int dt = 0; dt < 2; ++dt) {
                const s16x4 a0 = vtr(vs + (16 * s) * AT_VROW + dt * 64), a1 = vtr(vs + (16 * s + 8) * AT_VROW + dt * 64);
                const bf16x8 va = (bf16x8){a0[0], a0[1], a0[2], a0[3], a1[0], a1[1], a1[2], a1[3]};
                O[dt] = MFMA32(va, pb, O[dt]);
            }
        }
        if (ti + 1 < AT_NTILE) {
#pragma unroll
            for (int it = 0; it < 4; ++it) *(LAS v4u*)(vl + ((ti + 1) & 1) * AT_VSLOT + (vkey + 8 * it) * AT_VROW + vpiece * 16) = vn[it];
#pragma unroll
            for (int ks = 0; ks < 4; ++ks) kf[ks] = kn[ks];
        }
    }
    l += __shfl_xor(l, 32);
    const float il = 1.f / l;
    const size_t row = (size_t)b * SEQ + qpos;
    const bf16* zp = F.PROJ + row * NPROJ + PC_ZB + h * 64 + 4 * hh;
    bf16* op = F.MIX + row * DM + 512 + h * 64 + 4 * hh;
#pragma unroll
    for (int dt = 0; dt < 2; ++dt)
#pragma unroll
        for (int g = 0; g < 4; ++g) {
            const v2u z = *(const v2u*)(zp + 32 * dt + 8 * g);
            v2u o; o.x = cvtpk(O[dt][4 * g] * il * siluf(bflo(z.x)), O[dt][4 * g + 1] * il * siluf(bfhi(z.x))); o.y = cvtpk(O[dt][4 * g + 2] * il * siluf(bflo(z.y)), O[dt][4 * g + 3] * il * siluf(bfhi(z.y)));
            *(v2u*)(op + 32 * dt + 8 * g) = o;
        }
}
__device__ __forceinline__ float wave_max(float v) {
#pragma unroll
    for (int o = 1; o < 64; o <<= 1) v = fmaxf(v, __shfl_xor(v, o));
    return v;
}
__device__ __forceinline__ void attn_decode_item(Frame& F, int item) {
    int lane_ = threadIdx.x & 63; asm volatile("" : "+v"(lane_));
    const int lane = lane_, t = item & 3, h = (item >> 2) & 7, b = item >> 5;
    const size_t row = (size_t)NP + b * ST + t;
    float q[64]; ld_bf16x64(F.PROJ + row * NPROJ + PC_QB + h * 64, q);
    float s[7];
#pragma unroll
    for (int p = 0; p < 7; ++p) {
        const int k = lane + 64 * p, br = k / 129, j = k - 129 * br, d = br == 0 ? 1 : (br == 1 ? 4 : 16), idx = LBUF + t - d * j;
        float v = -INFINITY;
        if (k < 387) { if (idx >= LBUF) v = dot_bf16row(F.PROJ + ((size_t)NP + b * ST + (idx - LBUF)) * NPROJ + PC_KB + h * 64, q); else v = dot_f32row(F.in[I_CK] + ((size_t)b * LBUF + idx) * 512 + h * 64, q); v *= 0.125f; }
        s[p] = v;
    }
    float mx = s[0];
#pragma unroll
    for (int p = 1; p < 7; ++p) mx = fmaxf(mx, s[p]);
    mx = wave_max(mx);
    float o[64];
#pragma unroll
    for (int i = 0; i < 64; ++i) o[i] = 0.f;
    float ls = 0.f;
#pragma unroll
    for (int p = 0; p < 7; ++p) {
        const int k = lane + 64 * p, br = k / 129, j = k - 129 * br, d = br == 0 ? 1 : (br == 1 ? 4 : 16), idx = LBUF + t - d * j;
        if (k < 387) { const float pw = __expf(s[p] - mx); ls += pw;
            if (idx >= LBUF) axpy_bf16row(F.PROJ + ((size_t)NP + b * ST + (idx - LBUF)) * NPROJ + PC_VB + h * 64, pw, 1.f, o); else axpy_f32row(F.in[I_CV] + ((size_t)b * LBUF + idx) * 512 + h * 64, pw, 1.f, o); }
    }
    ls = wave_sum(ls);
    const float il = 1.f / ls;
    float mine = 0.f;
#pragma unroll
    for (int i = 0; i < 64; ++i) { const float tot = wave_sum(o[i]); mine = (lane == i) ? tot : mine; }
    const float z = bf2f(F.PROJ[row * NPROJ + PC_ZB + h * 64 + lane]);
    F.MIX[row * DM + 512 + h * 64 + lane] = (bf16)(cvtpk(mine * il * siluf(z), 0.f) & 0xffffu);
}

#ifndef MK_N_LAUNCHES
#define MK_N_LAUNCHES 1
#endif
constexpr int N_PHASES = 7, N_LAUNCHES = MK_N_LAUNCHES;
__global__ void __launch_bounds__(NTHR, 2) hymba_fwd(Args args) {
    extern __shared__ __attribute__((aligned(16))) unsigned char lds[];
    Frame F;
    F.lds = (LAS unsigned char*)lds;
    F.tid = threadIdx.x; F.lane = F.tid & 63; F.wave = __builtin_amdgcn_readfirstlane(F.tid >> 6); F.G = gridDim.x;
#pragma unroll
    for (int i = 0; i < 14; ++i) F.in[i] = args.in[i];
    F.out = args.out; F.ws = args.ws;
    F.WinT = (bf16*)(args.ws + WS_WIN); F.WoutT = (bf16*)(args.ws + WS_WOUT); F.XN = (bf16*)(args.ws + WS_XN); F.PROJ = (bf16*)(args.ws + WS_PROJ); F.MIX = (bf16*)(args.ws + WS_MIX);
    F.GB = (float*)(args.ws + WS_GB); F.OA = (float*)(args.ws + WS_OA);
    volatile LAS unsigned* MISC = (volatile LAS unsigned*)(F.lds + MISC_OFF);
    if (F.tid < 64) ((LAS unsigned*)(F.lds + MISC_OFF))[F.tid] = 0u;
    __syncthreads();
    unsigned* barw = (unsigned*)(args.ws + WS_CTL) + CW_BAR;
    XcdBarrier bar; bar.bar = barw; bar.x = 0; bar.st = nullptr;
    if (N_LAUNCHES == 1) bar = xcd_barrier_post(barw, MISC + 8);
    const int lo = args.ph_lo, hi = args.ph_hi;
#define IN(k) (lo <= (k) && (k) < hi)
#define BOTH(k) (IN(k) && IN((k) + 1))
#define GRID_BAR() do { if (N_LAUNCHES == 1) xcd_barrier(bar); } while (0)

    if (IN(0)) { p0_prologue(F); if (BOTH(0)) GRID_BAR(); }
    if (IN(1)) {
        pg8::Gemm g{F.XN, F.WinT, MT, NPROJ, DM}; pg8::StaticOrder S; S.init(MT, NPROJ, F.G, (int)blockIdx.x);
        pg8::EpiBf16 E{F.PROJ, NPROJ};
        pg8::gemm_phase<pg8::EpiBf16, pg8::StaticOrder, true, true>(F.lds, g, S, E);
        if (BOTH(1)) GRID_BAR();
    }
    if (IN(2)) {
        for (int p = blockIdx.x; p < NUNIT / 2; p += F.G) chunk_prep_pair(F, p);
        for (int u = 16 + blockIdx.x; u < 16 + SB * 4; u += F.G) dn_seq_unit(F, u);
        if (BOTH(2)) GRID_BAR();
    }
    if (IN(3)) {
        if (blockIdx.x < 16) dn_scan_unit(F, blockIdx.x);
        {
            LAS unsigned char* vl = F.lds + F.wave * AT_WAVE_LDS;
            gu32* qhead = (gu32*)(args.ws + WS_CTL) + CW_Q0;
            for (;;) {
                if (F.tid == 0) MISC[0] = __hip_atomic_fetch_add(qhead, 1u, RLX_AGENT);
                __syncthreads();
                const int unit = (int)MISC[0];
                __syncthreads();
                if (unit >= 1024 + 512) break;
                if (unit < 1024) attn_prompt_unit(F, unit * 8 + F.wave, vl); else attn_decode_item(F, (unit - 1024) * 8 + F.wave);
            }
        }
        copy_outputs(F);
        if (BOTH(3)) GRID_BAR();
    }
    if (IN(4)) { mix_a_finish(F); if (BOTH(4)) GRID_BAR(); }
    if (IN(5)) {
        pg8::Gemm g{F.MIX, F.WoutT, MT, DM, DM}; pg8::StaticOrder S; S.init(MT, DM, F.G, (int)blockIdx.x);
        pg8::EpiResF32 E{F.in[I_XP], F.in[I_XS], NP, F.out, DM};
        pg8::gemm_phase<pg8::EpiResF32, pg8::StaticOrder, true, true>(F.lds, g, S, E);
        if (BOTH(5)) GRID_BAR();
    }
    if (IN(6)) { final_norm(F); }
#undef IN
#undef BOTH
}

extern "C" void kernel_launch(void* const* d_in, const int* in_sizes, int n_in, void* d_out, int out_size, void* d_ws, size_t ws_size, hipStream_t stream) {
    static int grid = 0;
    if (grid == 0) {
        if (n_in != 14 || (size_t)out_size != O_END || ws_size < WS_END) { fprintf(stderr, "kernel_launch: unexpected shapes (n_in %d, out %d, ws %zu); nothing launched\n", n_in, out_size, ws_size); grid = -1; return; }
        int dev = 0, cus = 0, per_cu = 0;
        if (hipGetDevice(&dev) != hipSuccess || hipDeviceGetAttribute(&cus, hipDeviceAttributeMultiprocessorCount, dev) != hipSuccess) { grid = -1; return; }
        if (hipFuncSetAttribute((const void*)hymba_fwd, hipFuncAttributeMaxDynamicSharedMemorySize, LDS_BYTES) != hipSuccess) { fprintf(stderr, "kernel_launch: hipFuncSetAttribute failed\n"); grid = -1; return; }
        if (hipOccupancyMaxActiveBlocksPerMultiprocessor(&per_cu, (const void*)hymba_fwd, NTHR, LDS_BYTES) != hipSuccess || per_cu < 1) fprintf(stderr, "kernel_launch: occupancy query says %d\n", per_cu);
        (void)hipGetLastError();
        grid = cus;
    }
    if (grid < 0) return;
    if (hipMemsetAsync((char*)d_ws + WS_CTL, 0, CTL_ZERO_BYTES, stream) != hipSuccess) return;
    Args a{};
    for (int i = 0; i < 14; ++i) a.in[i] = (const float*)d_in[i];
    a.out = (float*)d_out; a.ws = (unsigned char*)d_ws;
    if (N_LAUNCHES == 1) { a.ph_lo = 0; a.ph_hi = N_PHASES; hipLaunchKernelGGL(hymba_fwd, dim3(grid), dim3(NTHR), LDS_BYTES, stream, a); }
    else for (int li = 0; li < N_PHASES; ++li) { a.ph_lo = li; a.ph_hi = li + 1; hipLaunchKernelGGL(hymba_fwd, dim3(grid), dim3(NTHR), LDS_BYTES, stream, a); }
}
```

```cpp
#include <hip/hip_runtime.h>
#include <cstdio>
#include <cstdint>
namespace pg8 {
#define PG8_LAS __attribute__((address_space(3)))
typedef unsigned short bf16_t;
typedef short bf16x8 __attribute__((ext_vector_type(8)));
typedef float f32x4 __attribute__((ext_vector_type(4)));
typedef unsigned u32x4 __attribute__((ext_vector_type(4)));
constexpr int BM = 256, BK = 64, HALF = 128, HTB = HALF * BK * 2  , STAGE_BYTES = 8 * HTB, NXCD = 8, WGM = 8;

__host__ __device__ __forceinline__ int lds_byte(int r, int c) { const int st = (r >> 4) * 2 + (c >> 5), rr = r & 15, cc = c & 31, ob = rr * 64 + cc * 2; return st * 1024 + (ob ^ (((ob >> 9) & 1) << 5)); }
__host__ __device__ __forceinline__ void stage_rc(int b, int& R, int& C) { const int st = b / 1024, sb = b % 1024, swz = sb ^ (((sb >> 9) & 1) << 5); R = (st >> 1) * 16 + swz / 64; C = (st & 1) * 32 + (swz % 64) / 2; }
__host__ __device__ __forceinline__ int perm32(int rho) { const int n = rho >> 4, i = rho & 15; return 8 * (i >> 2) + 4 * n + (i & 3); }

struct Unit { int pm, pn; };
struct Gemm { const bf16_t* A; const bf16_t* Bt; int M, N, K; };

struct StaticOrder {
    int nM, nN, nwg, G, c;
    __host__ __device__ void init(int M, int N, int G_, int c_) { nM = M / BM; nN = N / BM; nwg = nM * nN; G = G_; c = c_; }
    __host__ __device__ bool next(int i, Unit& u) const {
        const long L = (long)i * G + c; if (L >= nwg) return false;
        int wgid = (int)L; { const int q = nwg / NXCD, r = nwg % NXCD, xcd = wgid % NXCD, off = wgid / NXCD; wgid = (xcd < r ? xcd * (q + 1) : r * (q + 1) + (xcd - r) * q) + off; }
        const int nig = WGM * nN, gid = wgid / nig, fm = gid * WGM, gsz = (nM - fm) < WGM ? (nM - fm) : WGM;
        u.pm = fm + ((wgid % nig) % gsz); u.pn = (wgid % nig) / gsz; return true;
    }
    __device__ __forceinline__ void a_ready(const Unit&) const {}
    __device__ __forceinline__ void done(const Unit&) const {}
};

__device__ __forceinline__ unsigned cvt_pk_bf16(float lo, float hi) { unsigned r; asm volatile("v_cvt_pk_bf16_f32 %0, %1, %2" : "=v"(r) : "v"(lo), "v"(hi)); return r; }
typedef float f32x2 __attribute__((ext_vector_type(2)));
struct EpiBf16 {
    static constexpr bool PERM = true, AFTER_DRAIN = false;
    bf16_t* O; int ldc;
    __device__ __forceinline__ void operator()(const f32x4 (&acc)[2][2][4][2], const Unit& u, int wr, int wc, int fr, int fq) const {
        const int row0 = u.pm * BM + wr * 64 + fr; const int col0 = u.pn * BM + wc * 32 + 8 * fq;
#pragma unroll
        for (int ai = 0; ai < 2; ++ai)
#pragma unroll
            for (int m = 0; m < 4; ++m) { bf16_t* rowp = O + (size_t)(row0 + ai * HALF + m * 16) * ldc + col0;
#pragma unroll
                for (int bj = 0; bj < 2; ++bj) { const f32x4 v0 = acc[ai][bj][m][0], v1 = acc[ai][bj][m][1];
                    u32x4 w; w.x = cvt_pk_bf16(v0[0], v0[1]); w.y = cvt_pk_bf16(v0[2], v0[3]); w.z = cvt_pk_bf16(v1[0], v1[1]); w.w = cvt_pk_bf16(v1[2], v1[3]);
                    *(u32x4*)(rowp + bj * HALF) = w; } }
    }
};
struct EpiResF32 {
    static constexpr bool PERM = false, AFTER_DRAIN = false;
    const float* res0; const float* res1; int rows0; float* out; int ldc;
    __device__ __forceinline__ void operator()(const f32x4 (&acc)[2][2][4][2], const Unit& u, int wr, int wc, int fr, int fq) const {
        const int col0 = u.pn * BM + wc * 32 + 4 * fq;
#pragma unroll
        for (int ai = 0; ai < 2; ++ai)
#pragma unroll
            for (int m = 0; m < 4; ++m) { const int row = u.pm * BM + ai * HALF + wr * 64 + m * 16 + fr;
                const float* rp = (row < rows0 ? res0 + (size_t)row * ldc : res1 + (size_t)(row - rows0) * ldc) + col0;
                float* op = out + (size_t)row * ldc + col0;
#pragma unroll
                for (int bj = 0; bj < 2; ++bj)
#pragma unroll
                    for (int n = 0; n < 2; ++n) { const f32x4 r = *(const f32x4*)(rp + bj * HALF + n * 16); *(f32x4*)(op + bj * HALF + n * 16) = acc[ai][bj][m][n] + r; } }
    }
};
template <class Epi, class Sched, bool ALIGN_EPI = false, bool SP2 = false>
__device__ __forceinline__ void gemm_phase(PG8_LAS unsigned char* lds, const Gemm g, const Sched& S, const Epi& E) {
    const int tid = threadIdx.x, wid = __builtin_amdgcn_readfirstlane(tid >> 6), lane = tid & 63, wr = wid >> 2, wc = wid & 3, fr = lane & 15, fq = lane >> 4;
    const int K = g.K, nt = K / BK;
    unsigned voffA[2], voffB[2];
#pragma unroll
    for (int i = 0; i < 2; ++i) { int R, C; stage_rc(tid * 16 + i * 8192, R, C); const int Rb = Epi::PERM ? ((R & ~31) + perm32(R & 31)) : R;
        voffA[i] = (unsigned)(R * K + C) * 2u; voffB[i] = (unsigned)(Rb * K + C) * 2u; }
    const size_t kstep = (size_t)(BK * 2);
    const size_t hstep = (size_t)HALF * K * 2;
    const size_t tstep = 2 * hstep;
    const unsigned ldsw = (unsigned)wid * 1024u;
    const int aoff = lds_byte(wr * 64 + fr, fq * 8), boff = lds_byte(wc * 32 + fr, fq * 8);
#define PG8_SA(b, h) (((b) * 2 + (h)) * HTB)
#define PG8_SB(b, h) ((4 + (b) * 2 + (h)) * HTB)
#define PG8_STAGE(bufoff, gbase, voff) do { _Pragma("unroll") for (int _i = 0; _i < 2; ++_i) \
        __builtin_amdgcn_global_load_lds((const unsigned*)((const char*)(gbase) + (voff)[_i]), (PG8_LAS unsigned*)(lds + (bufoff) + ldsw + _i * 8192), 16, 0, 0); } while (0)
#define PG8_LDA(dst, b, h) do { _Pragma("unroll") for (int m = 0; m < 4; ++m) _Pragma("unroll") for (int k = 0; k < 2; ++k) dst[m][k] = *(const PG8_LAS bf16x8*)(lds + PG8_SA(b, h) + aoff + m * 2048 + k * 1024); } while (0)
#define PG8_LDB(dst, b, h) do { _Pragma("unroll") for (int n = 0; n < 2; ++n) _Pragma("unroll") for (int k = 0; k < 2; ++k) dst[n][k] = *(const PG8_LAS bf16x8*)(lds + PG8_SB(b, h) + boff + n * 2048 + k * 1024); } while (0)
#define PG8_MMA(ai, bj, At, Bt) do { __builtin_amdgcn_s_setprio(1); _Pragma("unroll") for (int m = 0; m < 4; ++m) _Pragma("unroll") for (int n = 0; n < 2; ++n) _Pragma("unroll") for (int k = 0; k < 2; ++k) \
        acc[ai][bj][m][n] = __builtin_amdgcn_mfma_f32_16x16x32_bf16(Bt[n][k], At[m][k], acc[ai][bj][m][n], 0, 0, 0); __builtin_amdgcn_s_setprio(0); } while (0)
#define PG8_WAIT_V(n) asm volatile("s_waitcnt vmcnt(" #n ")" ::: "memory")
#define PG8_WAIT_L(n) asm volatile("s_waitcnt lgkmcnt(" #n ")" ::: "memory")
#define PG8_BAR __builtin_amdgcn_s_barrier()
#define PG8_SCHED __builtin_amdgcn_sched_barrier(0)
    Unit cur, nxt; int ui = 0;
    if (!S.next(0, cur)) return;
    f32x4 acc[2][2][4][2];
#pragma unroll
    for (int a = 0; a < 2; ++a)
#pragma unroll
        for (int b = 0; b < 2; ++b)
#pragma unroll
            for (int m = 0; m < 4; ++m)
#pragma unroll
                for (int n = 0; n < 2; ++n) acc[a][b][m][n] = (f32x4){0.f, 0.f, 0.f, 0.f};
    bf16x8 At[4][2], B0[2][2], B1[2][2];
    const char* cA = (const char*)g.A + (size_t)cur.pm * tstep; const char* cB = (const char*)g.Bt + (size_t)cur.pn * tstep;
    S.a_ready(cur);
    if constexpr (SP2) {
        PG8_STAGE(PG8_SB(0, 0), cB, voffB); PG8_STAGE(PG8_SB(0, 1), cB + hstep, voffB); PG8_STAGE(PG8_SA(0, 0), cA, voffA); PG8_STAGE(PG8_SA(0, 1), cA + hstep, voffA);
        if (wr == 1) PG8_BAR;
        PG8_WAIT_V(2); PG8_BAR;
        PG8_STAGE(PG8_SB(1, 0), cB + kstep, voffB); PG8_STAGE(PG8_SA(1, 0), cA + kstep, voffA); PG8_STAGE(PG8_SB(1, 1), cB + hstep + kstep, voffB);
        PG8_WAIT_V(6); PG8_BAR;
    } else {
        PG8_STAGE(PG8_SB(0, 0), cB, voffB); PG8_STAGE(PG8_SA(0, 0), cA, voffA); PG8_STAGE(PG8_SB(0, 1), cB + hstep, voffB); PG8_STAGE(PG8_SA(0, 1), cA + hstep, voffA);
        if (wr == 1) PG8_BAR;
        PG8_WAIT_V(4); PG8_BAR;
        PG8_STAGE(PG8_SB(1, 0), cB + kstep, voffB); PG8_STAGE(PG8_SA(1, 0), cA + kstep, voffA); PG8_STAGE(PG8_SB(1, 1), cB + hstep + kstep, voffB);
        PG8_WAIT_V(6); PG8_BAR;
    }
    for (;;) {
        const bool has_next = S.next(ui + 1, nxt);
        const char* nA = has_next ? (const char*)g.A + (size_t)nxt.pm * tstep : cA; const char* nB = has_next ? (const char*)g.Bt + (size_t)nxt.pn * tstep : cB;
        for (int t = 0; t < nt; t += 2) {
            const bool last = (t == nt - 2);
            const char* a1 = cA + (size_t)(t + 1) * kstep;
            const char* a2 = last ? nA : cA + (size_t)(t + 2) * kstep; const char* b2 = last ? nB : cB + (size_t)(t + 2) * kstep;
            const char* a3 = a2 + kstep; const char* b3 = b2 + kstep;
            if (last && has_next) S.a_ready(nxt);
            if constexpr (SP2) {
            PG8_LDB(B0, 0, 0); PG8_LDB(B1, 0, 1); PG8_SCHED; PG8_LDA(At, 0, 0); PG8_STAGE(PG8_SA(1, 1), a1 + hstep, voffA);
            PG8_WAIT_V(8); PG8_WAIT_L(0); PG8_BAR; PG8_MMA(0, 0, At, B0); PG8_MMA(0, 1, At, B1); PG8_BAR; PG8_SCHED;
            PG8_LDA(At, 0, 1); PG8_STAGE(PG8_SB(0, 0), b2, voffB); PG8_STAGE(PG8_SB(0, 1), b2 + hstep, voffB); PG8_STAGE(PG8_SA(0, 0), a2, voffA);
            PG8_WAIT_V(8); PG8_WAIT_L(0); PG8_BAR; PG8_MMA(1, 0, At, B0); PG8_MMA(1, 1, At, B1); PG8_BAR; PG8_SCHED;
            PG8_LDB(B0, 1, 0); PG8_LDB(B1, 1, 1); PG8_SCHED; PG8_LDA(At, 1, 0); PG8_STAGE(PG8_SA(0, 1), a2 + hstep, voffA);
            PG8_WAIT_V(8); PG8_WAIT_L(0); PG8_BAR; PG8_MMA(0, 0, At, B0); PG8_MMA(0, 1, At, B1); PG8_BAR; PG8_SCHED;
            PG8_LDA(At, 1, 1); PG8_STAGE(PG8_SB(1, 0), b3, voffB); PG8_STAGE(PG8_SB(1, 1), b3 + hstep, voffB); PG8_STAGE(PG8_SA(1, 0), a3, voffA);
            PG8_WAIT_V(8); PG8_WAIT_L(0); PG8_BAR; PG8_MMA(1, 0, At, B0); PG8_MMA(1, 1, At, B1); PG8_BAR; PG8_SCHED;
            } else {
            PG8_LDB(B0, 0, 0); PG8_SCHED; PG8_LDA(At, 0, 0); PG8_STAGE(PG8_SA(1, 1), a1 + hstep, voffA);
            PG8_WAIT_L(8); PG8_BAR; PG8_WAIT_L(0); PG8_MMA(0, 0, At, B0); PG8_BAR; PG8_SCHED;
            PG8_LDB(B1, 0, 1); PG8_STAGE(PG8_SB(0, 0), b2, voffB);
            PG8_BAR; PG8_WAIT_L(0); PG8_MMA(0, 1, At, B1); PG8_BAR;
            PG8_LDA(At, 0, 1); PG8_STAGE(PG8_SA(0, 0), a2, voffA);
            PG8_BAR; PG8_WAIT_L(0); PG8_MMA(1, 0, At, B0); PG8_BAR; PG8_SCHED;
            PG8_STAGE(PG8_SB(0, 1), b2 + hstep, voffB);
            PG8_WAIT_V(6); PG8_BAR; PG8_MMA(1, 1, At, B1); PG8_BAR;
            PG8_LDB(B0, 1, 0); PG8_SCHED; PG8_LDA(At, 1, 0); PG8_STAGE(PG8_SA(0, 1), a2 + hstep, voffA);
            PG8_WAIT_L(8); PG8_BAR; PG8_WAIT_L(0); PG8_MMA(0, 0, At, B0); PG8_BAR; PG8_SCHED;
            PG8_LDB(B1, 1, 1); PG8_STAGE(PG8_SB(1, 0), b3, voffB);
            PG8_BAR; PG8_WAIT_L(0); PG8_MMA(0, 1, At, B1); PG8_BAR;
            PG8_LDA(At, 1, 1); PG8_STAGE(PG8_SA(1, 0), a3, voffA);
            PG8_BAR; PG8_WAIT_L(0); PG8_MMA(1, 0, At, B0); PG8_BAR; PG8_SCHED;
            PG8_STAGE(PG8_SB(1, 1), b3 + hstep, voffB);
            PG8_WAIT_V(6); PG8_BAR; PG8_MMA(1, 1, At, B1); PG8_BAR;
            }
        }
        if constexpr (ALIGN_EPI) { if (wr == 0) PG8_BAR; }
        if constexpr (!Epi::AFTER_DRAIN) { E(acc, cur, wr, wc, fr, fq); S.done(cur); }
        if (!has_next) break;
#pragma unroll
        for (int a = 0; a < 2; ++a)
#pragma unroll
            for (int b = 0; b < 2; ++b)
#pragma unroll
                for (int m = 0; m < 4; ++m)
#pragma unroll
                    for (int n = 0; n < 2; ++n) acc[a][b][m][n] = (f32x4){0.f, 0.f, 0.f, 0.f};
        cur = nxt; cA = nA; cB = nB; ++ui;
        if constexpr (ALIGN_EPI) { if (wr == 1) PG8_BAR; }
    }
    PG8_WAIT_V(0);
    if constexpr (!ALIGN_EPI) { if (wr == 0) PG8_BAR; }
    PG8_BAR;
    if constexpr (Epi::AFTER_DRAIN) { E.fused(acc, cur, wr, wc, fr, fq, lds, wid, lane); S.done(cur); }
#undef PG8_SA
#undef PG8_SB
#undef PG8_STAGE
#undef PG8_LDA
#undef PG8_LDB
#undef PG8_MMA
#undef PG8_WAIT_V
#undef PG8_WAIT_L
#undef PG8_BAR
#undef PG8_SCHED
}
}
#define GAS __attribute__((address_space(1)))
#define LAS __attribute__((address_space(3)))
typedef unsigned short bf16;
typedef unsigned v4u __attribute__((ext_vector_type(4)));
typedef float f32x4 __attribute__((ext_vector_type(4)));
typedef short bf16x8 __attribute__((ext_vector_type(8)));
typedef GAS unsigned gu32;
typedef GAS unsigned long long gu64;
#define RLX_AGENT __ATOMIC_RELAXED, __HIP_MEMORY_SCOPE_AGENT
#define LDS_WAIT() asm volatile("s_waitcnt lgkmcnt(0)" ::: "memory")
#define VM_WAIT() asm volatile("s_waitcnt vmcnt(0)" ::: "memory")
__device__ __forceinline__ unsigned long long rt() { return __builtin_amdgcn_s_memrealtime(); }
__device__ __forceinline__ unsigned f2bf(float f) { unsigned u = __builtin_bit_cast(unsigned, f); return (u + 0x7fffu + ((u >> 16) & 1u)) >> 16; }
__device__ __forceinline__ unsigned pk2(float lo, float hi) { return f2bf(lo) | (f2bf(hi) << 16); }

#define XB_TMO      128
#define XB_XCNT(j)  (256  + 64 * (j))
#define XB_XSUB(j)  (1280 + 64 * (j))
#define XB_XGEN(j)  (2304 + 64 * (j))
#define XB_TOP      3328
#define XB_TOPGEN   3392
#define XCD_BAR_WORDS 3456
#define XB_SPIN_CAP (1u << 18)

__device__ __forceinline__ unsigned xb_ld(unsigned* p)              { return __hip_atomic_load(p, __ATOMIC_RELAXED, __HIP_MEMORY_SCOPE_AGENT); }
__device__ __forceinline__ unsigned xb_add(unsigned* p, unsigned v) { return __hip_atomic_fetch_add(p, v, __ATOMIC_RELAXED, __HIP_MEMORY_SCOPE_AGENT); }
__device__ __forceinline__ unsigned xb_xcc_id() { return (unsigned)__builtin_amdgcn_s_getreg((3 << 11) | 20) & 0xFu; }
#define XB_SPIN(cond, bar) do { unsigned _sp = 0; while (cond) { __builtin_amdgcn_s_sleep(1); \
    if ((++_sp & 255u) == 0u) { if (xb_ld(&(bar)[XB_TMO])) break; if (_sp > XB_SPIN_CAP) { atomicAdd(&(bar)[XB_TMO], 1u); break; } } } } while (0)

struct XcdBarrier {
    unsigned* bar; unsigned x;
    volatile LAS unsigned* st;
};

__device__ __forceinline__ XcdBarrier xcd_barrier_post(unsigned* bar, volatile LAS unsigned* st) {
    XcdBarrier b; b.bar = bar; b.x = xb_xcc_id(); b.st = st;
    if (threadIdx.x == 0) (void)xb_add(&bar[XB_XCNT(b.x)], 1u);
    return b;
}
__device__ __forceinline__ void xcd_barrier_complete(unsigned* bar, unsigned x, unsigned& nloc, unsigned& nx) {
    const unsigned G = gridDim.x * gridDim.y * gridDim.z;
    unsigned sum, cnt, mine, sp = 0u;
    for (;;) {
        sum = 0u; cnt = 0u; mine = 0u;
#pragma unroll
        for (unsigned j = 0; j < 16; ++j) { const unsigned c = xb_ld(&bar[XB_XCNT(j)]); sum += c; cnt += (c > 0u) ? 1u : 0u; mine = (j == x) ? c : mine; }
        if (sum == G) break;
        __builtin_amdgcn_s_sleep(1);
        if ((++sp & 255u) == 0u) { if (xb_ld(&bar[XB_TMO])) break; if (sp > XB_SPIN_CAP) { atomicAdd(&bar[XB_TMO], 1u); break; } }
    }
    nloc = mine > 0u ? mine : 1u; nx = cnt > 0u ? cnt : 1u;
}

__device__ __forceinline__ void xcd_barrier(const XcdBarrier& b) {
    asm volatile("s_waitcnt vmcnt(0)" ::: "memory");
    __syncthreads();
    if (threadIdx.x == 0) {
        unsigned* bar = b.bar;
        __builtin_amdgcn_s_waitcnt(0);
        unsigned nloc = b.st[0], nx = b.st[1];
        if (nloc == 0u) { xcd_barrier_complete(bar, b.x, nloc, nx); b.st[0] = nloc; b.st[1] = nx; }
        const unsigned old = xb_add(&bar[XB_XSUB(b.x)], 1u);
        const unsigned gen = old / nloc;
        if (old + 1u == (gen + 1u) * nloc) {
            __builtin_amdgcn_fence(__ATOMIC_RELEASE, "agent");
            asm volatile("s_waitcnt vmcnt(0)" ::: "memory");
            const unsigned og = xb_add(&bar[XB_TOP], 1u);
            const unsigned tg = og / nx;
            if (og + 1u == (tg + 1u) * nx) xb_add(&bar[XB_TOPGEN], 1u);
            else XB_SPIN(xb_ld(&bar[XB_TOPGEN]) == tg, bar);
            __builtin_amdgcn_fence(__ATOMIC_ACQUIRE, "agent");
            xb_add(&bar[XB_XGEN(b.x)], 1u);
            asm volatile("s_waitcnt vmcnt(0)" ::: "memory");
        } else {
            XB_SPIN(xb_ld(&bar[XB_XGEN(b.x)]) == gen, bar);
            __builtin_amdgcn_fence(__ATOMIC_ACQUIRE, "agent");
            asm volatile("s_waitcnt vmcnt(0)" ::: "memory");
        }
    }
    __syncthreads();
}

constexpr int DM = 1024, SEQ = 8192, PB = 4, SB = 128, ST = 4, LBUF = 2048;
constexpr int NP = PB * SEQ;
constexpr int NS = SB * ST;
constexpr int MT = NP + NS;
constexpr int DIN = 4104, NPROJ = 4096;
constexpr int CONVCH = 1536;
constexpr int PC_ZA = 1536, PC_QB = 2048, PC_KB = 2560, PC_VB = 3072, PC_ZB = 3584;
constexpr float NORM_EPS = 1e-6f;
constexpr size_t O_YP = 0, O_YS = (size_t)NP * DM, O_CONVP = O_YS + (size_t)NS * DM, O_DELTAP = O_CONVP + (size_t)PB * 3 * CONVCH,
                 O_KWP = O_DELTAP + (size_t)PB * 4 * 128 * 128, O_VWP = O_KWP + (size_t)PB * LBUF * 512, O_CONVS = O_VWP + (size_t)PB * LBUF * 512,
                 O_DELTAS = O_CONVS + (size_t)SB * 3 * CONVCH, O_KWS = O_DELTAS + (size_t)SB * 4 * 128 * 128, O_VWS = O_KWS + (size_t)SB * LBUF * 512,
                 O_END = O_VWS + (size_t)SB * LBUF * 512;
constexpr size_t MiB = 1u << 20;
constexpr size_t WS_CTL = 0, CTL_ZERO_BYTES = 1 * MiB;
constexpr size_t WS_WIN = 2 * MiB, WS_WOUT = 10 * MiB, WS_GB = 12 * MiB, WS_XN = 16 * MiB, WS_PROJ = 96 * MiB, WS_OA = 360 * MiB, WS_MIX = 432 * MiB, WS_CHK = 512 * MiB, WS_UT = 624 * MiB, WS_GL = 656 * MiB, WS_END = 657 * MiB;
constexpr int CW_TMO = 0, CW_Q0 = 64, CW_QC = 128, CW_G1DONE = 192, CW_BAR = 4096;
constexpr int G1_GEMM_WGS = 208, P3_COPY_WGS = 80;
constexpr int LDS_BYTES = 147456, MISC_OFF = LDS_BYTES - 256;
constexpr int NWAVES = 8, NTHR = 512;

struct Args { const float* in[14]; float* out; unsigned char* ws; int ph_lo, ph_hi; };
enum { I_XP = 0, I_XS, I_SCONV, I_SDELTA, I_CK, I_CV, I_NORMG, I_FNORMG, I_WIN, I_CONVW, I_ALOG, I_DTB, I_DNG, I_WOUT };

struct Frame {
    LAS unsigned char* lds;
    int tid, lane, wave, G;
    const float* in[14]; float* out; unsigned char* ws;
    bf16 *WinT, *WoutT, *XN, *PROJ, *MIX; float *GB, *OA;
};

__device__ __forceinline__ float wave_sum(float v) {
#pragma unroll
    for (int o = 1; o < 64; o <<= 1) v += __shfl_xor(v, o);
    return v;
}
__device__ __forceinline__ float bf2f(bf16 v) { return __uint_as_float((unsigned)v << 16); }
__device__ __forceinline__ float bflo(unsigned w) { return __uint_as_float(w << 16); }
__device__ __forceinline__ float bfhi(unsigned w) { return __uint_as_float(w & 0xffff0000u); }
__device__ __forceinline__ float siluf(float y) { return y / (1.f + __expf(-y)); }

__device__ __forceinline__ void p0_transpose_item(const float* W, int K, int ldw, int c0, bf16* WT, int n0, int k0, LAS float* scr, int lane) {
#pragma unroll 8
    for (int i = 0; i < 32; ++i) { const int kk = 2 * i + (lane >> 5); scr[kk * 33 + (lane & 31)] = W[(size_t)(k0 + kk) * ldw + c0 + (lane & 31)]; }
    LDS_WAIT(); asm volatile("" ::: "memory");
    const int c = lane & 7;
#pragma unroll
    for (int j = 0; j < 4; ++j) { const int n = (lane >> 3) + 8 * j; const LAS float* s = scr + (8 * c) * 33 + n;
        v4u o; o.x = pk2(s[0 * 33], s[1 * 33]); o.y = pk2(s[2 * 33], s[3 * 33]); o.z = pk2(s[4 * 33], s[5 * 33]); o.w = pk2(s[6 * 33], s[7 * 33]);
        *(GAS v4u*)(WT + (size_t)(n0 + n) * K + k0 + 8 * c) = o; }
    LDS_WAIT(); asm volatile("" ::: "memory");
}
__device__ __forceinline__ void p0_prologue(Frame& F) {
    LAS float* W8T = (LAS float*)(F.lds);
    const float* w_in = F.in[I_WIN];
    for (int i = F.tid; i < 8 * 1024; i += NTHR) { const int k = i >> 3, e = i & 7; W8T[e * 1024 + k] = w_in[(size_t)k * DIN + 2048 + e]; }
    __syncthreads();
    const int gw = blockIdx.x * NWAVES + F.wave, NGW = F.G * NWAVES;
    const float* ng = F.in[I_NORMG];
    f32x4 gv[4];
#pragma unroll
    for (int j = 0; j < 4; ++j) gv[j] = *(const f32x4*)(ng + 4 * F.lane + 256 * j);
    const float a_log_l = (F.lane < 4) ? F.in[I_ALOG][F.lane] : 0.f, dtb_l = (F.lane < 4) ? F.in[I_DTB][F.lane] : 0.f;
    for (int m = gw; m < MT; m += NGW) {
        const float* xrow = (m < NP) ? F.in[I_XP] + (size_t)m * DM : F.in[I_XS] + (size_t)(m - NP) * DM;
        const GAS f32x4* xr = (const GAS f32x4*)xrow + F.lane;
        f32x4 v[4]; float s = 0.f;
#pragma unroll
        for (int j = 0; j < 4; ++j) { v[j] = xr[64 * j]; s += (v[j].x * v[j].x + v[j].y * v[j].y) + (v[j].z * v[j].z + v[j].w * v[j].w); }
        const float rs = 1.f / sqrtf(wave_sum(s) * (1.f / DM) + NORM_EPS);
#pragma unroll
        for (int j = 0; j < 4; ++j) v[j] = v[j] * rs * gv[j];
        GAS unsigned long long* o8 = (GAS unsigned long long*)(F.XN + (size_t)m * DM) + F.lane;
#pragma unroll
        for (int j = 0; j < 4; ++j) o8[64 * j] = (unsigned long long)pk2(v[j].x, v[j].y) | ((unsigned long long)pk2(v[j].z, v[j].w) << 32);
        float d[8];
#pragma unroll
        for (int e = 0; e < 8; ++e) { float acc = 0.f;
#pragma unroll
            for (int j = 0; j < 4; ++j) { const f32x4 w = *(const LAS f32x4*)(W8T + e * 1024 + 4 * F.lane + 256 * j); acc += (v[j].x * w.x + v[j].y * w.y) + (v[j].z * w.z + v[j].w * w.w); }
            d[e] = wave_sum(acc); }
        float mine = 0.f;
#pragma unroll
        for (int e = 0; e < 8; ++e) mine = (F.lane == e) ? d[e] : mine;
        if (F.lane < 4) { const float xx = mine + dtb_l; const float sp = xx > 20.f ? xx : log1pf(expf(xx)); F.GB[(size_t)m * 8 + F.lane] = -expf(a_log_l) * sp; }
        else if (F.lane < 8) { F.GB[(size_t)m * 8 + F.lane] = 1.f / (1.f + expf(-mine)); }
    }
    __syncthreads();
    LAS float* scr = (LAS float*)(F.lds + 32768 + F.wave * 8448);
    constexpr int I_IN = (DM / 64) * (NPROJ / 32), I_OUT = (DM / 64) * (DM / 32);
    for (int it = gw; it < I_IN + I_OUT; it += NGW) {
        if (it < I_IN) { const int kb = it / (NPROJ / 32), nb = it % (NPROJ / 32), n0 = nb * 32; p0_transpose_item(w_in, DM, DIN, n0 + (n0 >= 2048 ? 8 : 0), F.WinT, n0, kb * 64, scr, F.lane); }
        else { const int r = it - I_IN, kb = r / (DM / 32), nb = r % (DM / 32); p0_transpose_item(F.in[I_WOUT], DM, DM, nb * 32, F.WoutT, nb * 32, kb * 64, scr, F.lane); }
    }
}

__device__ __forceinline__ void dn_seq_unit(Frame& F, int unit) {
    LAS float* cv = (LAS float*)F.lds;
    LAS float* part = cv + 384;
    LAS float* psum = cv + 512;
    LAS float* osum = cv + 1024;
    const int t = F.tid, dv = t & 127, qd = t >> 7;
    int L, row0, h; const float* prefix; const float* S0; float* Sout;
    if (unit < 16) { const int b = unit >> 2; h = unit & 3; L = SEQ; row0 = b * SEQ; prefix = nullptr; S0 = nullptr; Sout = F.out + O_DELTAP + (size_t)unit * 16384; }
    else { const int u = unit - 16, b = u >> 2; h = u & 3; L = ST; row0 = NP + b * ST; prefix = F.in[I_SCONV] + (size_t)b * 3 * CONVCH; S0 = F.in[I_SDELTA] + (size_t)u * 16384; Sout = F.out + O_DELTAS + (size_t)u * 16384; }
    float S[32];
#pragma unroll
    for (int i = 0; i < 32; ++i) S[i] = S0 ? S0[(size_t)(qd * 32 + i) * 128 + dv] : 0.f;
    const int which = t >> 7, ch = t & 127, gcol = (which < 3 ? which : 0) * 512 + h * 128 + ch;
    float w0 = 0.f, w1 = 0.f, w2 = 0.f, w3 = 0.f, x0 = 0.f, x1 = 0.f, x2 = 0.f;
    if (t < 384) { const float* cw = F.in[I_CONVW]; w0 = cw[gcol]; w1 = cw[CONVCH + gcol]; w2 = cw[2 * CONVCH + gcol]; w3 = cw[3 * CONVCH + gcol];
        if (prefix) { x0 = prefix[gcol]; x1 = prefix[CONVCH + gcol]; x2 = prefix[2 * CONVCH + gcol]; } }
    __syncthreads();
    for (int tau = 0; tau < L; ++tau) {
        const size_t row = (size_t)(row0 + tau);
        float ss = 0.f;
        if (t < 384) { const float x3 = bf2f(F.PROJ[row * NPROJ + gcol]); float y = w0 * x0 + w1 * x1 + w2 * x2 + w3 * x3; x0 = x1; x1 = x2; x2 = x3; y = siluf(y); cv[t] = y; ss = (t < 256) ? y * y : 0.f; }
        if (F.wave < 4) { ss = wave_sum(ss); if (F.lane == 0) part[F.wave] = ss; }
        __syncthreads();
        const float qn = (1.f / sqrtf(part[0] + part[1] + NORM_EPS)) * 0.08838834764831845f, kn = 1.f / sqrtf(part[2] + part[3] + NORM_EPS);
        const float g = F.GB[row * 8 + h], beta = F.GB[row * 8 + 4 + h], a = expf(g);
        float p = 0.f;
#pragma unroll
        for (int i = 0; i < 32; ++i) { S[i] *= a; p += S[i] * cv[128 + qd * 32 + i]; }
        psum[qd * 128 + dv] = p * kn;
        __syncthreads();
        const float ptot = (psum[dv] + psum[128 + dv]) + (psum[256 + dv] + psum[384 + dv]);
        const float r = beta * (cv[256 + dv] - ptot);
        float o = 0.f;
#pragma unroll
        for (int i = 0; i < 32; ++i) { S[i] += (cv[128 + qd * 32 + i] * kn) * r; o += S[i] * cv[qd * 32 + i]; }
        osum[qd * 128 + dv] = o * qn;
        __syncthreads();
        if (qd == 0) F.OA[row * 512 + h * 128 + dv] = (osum[dv] + osum[128 + dv]) + (osum[256 + dv] + osum[384 + dv]);
    }
#pragma unroll
    for (int i = 0; i < 32; ++i) Sout[(size_t)(qd * 32 + i) * 128 + dv] = S[i];
    __syncthreads();
}

__device__ __forceinline__ void ld_bf16x64(const bf16* p, float (&v)[64]) {
    const v4u* p4 = (const v4u*)p;
#pragma unroll
    for (int i = 0; i < 8; ++i) { const v4u w = p4[i]; v[8 * i] = bflo(w.x); v[8 * i + 1] = bfhi(w.x); v[8 * i + 2] = bflo(w.y); v[8 * i + 3] = bfhi(w.y); v[8 * i + 4] = bflo(w.z); v[8 * i + 5] = bfhi(w.z); v[8 * i + 6] = bflo(w.w); v[8 * i + 7] = bfhi(w.w); }
}
__device__ __forceinline__ float dot_bf16row(const bf16* p, const float (&q)[64]) {
    const v4u* p4 = (const v4u*)p; float s = 0.f;
#pragma unroll
    for (int i = 0; i < 8; ++i) { const v4u w = p4[i]; s += q[8 * i] * bflo(w.x) + q[8 * i + 1] * bfhi(w.x) + q[8 * i + 2] * bflo(w.y) + q[8 * i + 3] * bfhi(w.y) + q[8 * i + 4] * bflo(w.z) + q[8 * i + 5] * bfhi(w.z) + q[8 * i + 6] * bflo(w.w) + q[8 * i + 7] * bfhi(w.w); }
    return s;
}
__device__ __forceinline__ void axpy_bf16row(const bf16* p, float a, float sc, float (&o)[64]) {
    const v4u* p4 = (const v4u*)p;
#pragma unroll
    for (int i = 0; i < 8; ++i) { const v4u w = p4[i];
        o[8 * i] = o[8 * i] * sc + a * bflo(w.x); o[8 * i + 1] = o[8 * i + 1] * sc + a * bfhi(w.x); o[8 * i + 2] = o[8 * i + 2] * sc + a * bflo(w.y); o[8 * i + 3] = o[8 * i + 3] * sc + a * bfhi(w.y);
        o[8 * i + 4] = o[8 * i + 4] * sc + a * bflo(w.z); o[8 * i + 5] = o[8 * i + 5] * sc + a * bfhi(w.z); o[8 * i + 6] = o[8 * i + 6] * sc + a * bflo(w.w); o[8 * i + 7] = o[8 * i + 7] * sc + a * bfhi(w.w); }
}
__device__ __forceinline__ float dot_f32row(const float* p, const float (&q)[64]) {
    const f32x4* p4 = (const f32x4*)p; float s = 0.f;
#pragma unroll
    for (int i = 0; i < 16; ++i) { const f32x4 w = p4[i]; s += q[4 * i] * w.x + q[4 * i + 1] * w.y + q[4 * i + 2] * w.z + q[4 * i + 3] * w.w; }
    return s;
}
__device__ __forceinline__ void axpy_f32row(const float* p, float a, float sc, float (&o)[64]) {
    const f32x4* p4 = (const f32x4*)p;
#pragma unroll
    for (int i = 0; i < 16; ++i) { const f32x4 w = p4[i]; o[4 * i] = o[4 * i] * sc + a * w.x; o[4 * i + 1] = o[4 * i + 1] * sc + a * w.y; o[4 * i + 2] = o[4 * i + 2] * sc + a * w.z; o[4 * i + 3] = o[4 * i + 3] * sc + a * w.w; }
}
__device__ __forceinline__ void attn_write(Frame& F, size_t row, int h, const float (&o)[64], float l) {
    float z[64]; ld_bf16x64(F.PROJ + row * NPROJ + PC_ZB + h * 64, z);
    const float il = 1.f / l;
    v4u* dst = (v4u*)(F.MIX + row * DM + 512 + h * 64);
#pragma unroll
    for (int i = 0; i < 8; ++i) { v4u w; w.x = pk2(o[8 * i] * il * siluf(z[8 * i]), o[8 * i + 1] * il * siluf(z[8 * i + 1])); w.y = pk2(o[8 * i + 2] * il * siluf(z[8 * i + 2]), o[8 * i + 3] * il * siluf(z[8 * i + 3]));
        w.z = pk2(o[8 * i + 4] * il * siluf(z[8 * i + 4]), o[8 * i + 5] * il * siluf(z[8 * i + 5])); w.w = pk2(o[8 * i + 6] * il * siluf(z[8 * i + 6]), o[8 * i + 7] * il * siluf(z[8 * i + 7])); dst[i] = w; }
}
__device__ __forceinline__ void attn_simple(Frame& F) {
    const int gt = blockIdx.x * NTHR + F.tid, NGT = F.G * NTHR;
    for (int it = gt; it < PB * 8 * SEQ; it += NGT) {
        const int bh = it >> 13, pos = it & (SEQ - 1), b = bh >> 3, h = bh & 7; const size_t row = (size_t)b * SEQ + pos;
        float q[64]; ld_bf16x64(F.PROJ + row * NPROJ + PC_QB + h * 64, q);
#pragma unroll
        for (int i = 0; i < 64; ++i) q[i] *= 0.125f;
        float o[64];
#pragma unroll
        for (int i = 0; i < 64; ++i) o[i] = 0.f;
        float m = -INFINITY, l = 0.f;
        for (int br = 0; br < 3; ++br) { const int d = br == 0 ? 1 : (br == 1 ? 4 : 16);
            for (int j = 0; j <= 128; ++j) { const int kp = pos - d * j; if (kp < 0) break;
                const bf16* kr = F.PROJ + ((size_t)b * SEQ + kp) * NPROJ + h * 64;
                const float s = dot_bf16row(kr + PC_KB, q); const float mn = fmaxf(m, s), sc = __expf(m - mn), p = __expf(s - mn);
                l = l * sc + p; axpy_bf16row(kr + PC_VB, p, sc, o); m = mn; } }
        attn_write(F, row, h, o, l);
    }
    for (int it = gt; it < SB * 8 * ST; it += NGT) {
        const int t = it & 3, bh = it >> 2, b = bh >> 3, h = bh & 7; const size_t row = (size_t)NP + b * ST + t;
        float q[64]; ld_bf16x64(F.PROJ + row * NPROJ + PC_QB + h * 64, q);
#pragma unroll
        for (int i = 0; i < 64; ++i) q[i] *= 0.125f;
        float o[64];
#pragma unroll
        for (int i = 0; i < 64; ++i) o[i] = 0.f;
        float m = -INFINITY, l = 0.f;
        for (int br = 0; br < 3; ++br) { const int d = br == 0 ? 1 : (br == 1 ? 4 : 16);
            for (int j = 0; j <= 128; ++j) { const int idx = LBUF + t - d * j; if (idx < 0) break;
                float s;
                if (idx >= LBUF) { const bf16* kr = F.PROJ + ((size_t)NP + b * ST + (idx - LBUF)) * NPROJ + h * 64; s = dot_bf16row(kr + PC_KB, q);
                    const float mn = fmaxf(m, s), sc = __expf(m - mn), p = __expf(s - mn); l = l * sc + p; axpy_bf16row(kr + PC_VB, p, sc, o); m = mn; }
                else { const size_t off = ((size_t)b * LBUF + idx) * 512 + h * 64; s = dot_f32row(F.in[I_CK] + off, q);
                    const float mn = fmaxf(m, s), sc = __expf(m - mn), p = __expf(s - mn); l = l * sc + p; axpy_f32row(F.in[I_CV] + off, p, sc, o); m = mn; } } }
        attn_write(F, row, h, o, l);
    }
}

__device__ __forceinline__ f32x4 ld4bf(const bf16* p) { const unsigned long long w = *(const unsigned long long*)p; return (f32x4){bflo((unsigned)w), bfhi((unsigned)w), bflo((unsigned)(w >> 32)), bfhi((unsigned)(w >> 32))}; }
constexpr int CC_ROWS = 73, CC_PER_B = (LBUF - ST) / CC_ROWS, CC_N = 2 * SB * CC_PER_B, CC_F4 = CC_ROWS * 128;
static_assert(CC_ROWS * CC_PER_B == LBUF - ST, "copy chunking");
__device__ __forceinline__ void copy_chunk(Frame& F, int id) {
    const int which = id / (SB * CC_PER_B), rem = id % (SB * CC_PER_B), b = rem / CC_PER_B, piece = rem % CC_PER_B;
    const f32x4* src = (const f32x4*)(F.in[which ? I_CV : I_CK] + ((size_t)b * LBUF + ST + piece * CC_ROWS) * 512);
    f32x4* dst = (f32x4*)(F.out + (which ? O_VWS : O_KWS) + ((size_t)b * LBUF + piece * CC_ROWS) * 512);
    int i = F.tid;
    for (; i + 3 * NTHR < CC_F4; i += 4 * NTHR) {
        const f32x4 a = __builtin_nontemporal_load(src + i), b4 = __builtin_nontemporal_load(src + i + NTHR), c = __builtin_nontemporal_load(src + i + 2 * NTHR), d = __builtin_nontemporal_load(src + i + 3 * NTHR);
        __builtin_nontemporal_store(a, dst + i); __builtin_nontemporal_store(b4, dst + i + NTHR); __builtin_nontemporal_store(c, dst + i + 2 * NTHR); __builtin_nontemporal_store(d, dst + i + 3 * NTHR);
    }
    for (; i < CC_F4; i += NTHR) __builtin_nontemporal_store(__builtin_nontemporal_load(src + i), dst + i);
}
__device__ __forceinline__ void copy_pull(Frame& F, volatile LAS unsigned* MISC, gu32* qhead, gu32* stop_word, unsigned stop_at) {
    for (;;) {
        if (F.tid == 0) { unsigned id = 0xffffffffu; if (!stop_word || __hip_atomic_load(stop_word, RLX_AGENT) < stop_at) id = __hip_atomic_fetch_add(qhead, 1u, RLX_AGENT); MISC[1] = id; }
        __syncthreads();
        const unsigned id = MISC[1];
        __syncthreads();
        if (id >= (unsigned)CC_N) break;
        copy_chunk(F, (int)id);
    }
}
__device__ __forceinline__ void small_outputs(Frame& F) {
    const size_t gt = (size_t)blockIdx.x * NTHR + F.tid, NGT = (size_t)F.G * NTHR;
    for (size_t i = gt; i < (size_t)2 * SB * ST * 128; i += NGT) {
        const int c4 = (int)(i & 127), rr = (int)(i >> 7), t = rr & 3, b = (rr >> 2) & (SB - 1), which = rr >> 9;
        *(f32x4*)(F.out + (which ? O_VWS : O_KWS) + ((size_t)b * LBUF + (LBUF - ST) + t) * 512 + c4 * 4) = ld4bf(F.PROJ + ((size_t)NP + b * ST + t) * NPROJ + (which ? PC_VB : PC_KB) + c4 * 4);
    }
    for (size_t i = gt; i < ((size_t)2 << 20); i += NGT) {
        const int which = (int)(i >> 20); const size_t rem = i & (((size_t)1 << 20) - 1); const int b = (int)(rem >> 18), w = (int)(rem & ((1 << 18) - 1)), r = w >> 7, c4 = w & 127;
        *(f32x4*)(F.out + (which ? O_VWP : O_KWP) + rem * 4) = ld4bf(F.PROJ + ((size_t)b * SEQ + (SEQ - LBUF) + r) * NPROJ + (which ? PC_VB : PC_KB) + c4 * 4);
    }
    for (size_t i = gt; i < (size_t)(PB + SB) * 3 * (CONVCH / 4); i += NGT) {
        const int c4 = (int)(i % (CONVCH / 4)), rr = (int)(i / (CONVCH / 4)), j = rr % 3, b = rr / 3;
        if (b < PB) *(f32x4*)(F.out + O_CONVP + ((size_t)b * 3 + j) * CONVCH + c4 * 4) = ld4bf(F.PROJ + ((size_t)b * SEQ + SEQ - 3 + j) * NPROJ + c4 * 4);
        else { const int bs = b - PB; *(f32x4*)(F.out + O_CONVS + ((size_t)bs * 3 + j) * CONVCH + c4 * 4) = ld4bf(F.PROJ + ((size_t)NP + bs * ST + 1 + j) * NPROJ + c4 * 4); }
    }
}

__device__ __forceinline__ void mix_a_finish(Frame& F) {
    const int gw = blockIdx.x * NWAVES + F.wave, NGW = F.G * NWAVES;
    const float g0 = F.in[I_DNG][2 * F.lane], g1 = F.in[I_DNG][2 * F.lane + 1];
    for (int it = gw; it < MT * 4; it += NGW) {
        const size_t row = (size_t)(it >> 2); const int h = it & 3;
        const float2 v = *(const float2*)(F.OA + row * 512 + h * 128 + 2 * F.lane);
        const float rs = 1.f / sqrtf(wave_sum(v.x * v.x + v.y * v.y) * (1.f / 128.f) + NORM_EPS);
        const unsigned zw = *(const unsigned*)(F.PROJ + row * NPROJ + PC_ZA + h * 128 + 2 * F.lane);
        *(unsigned*)(F.MIX + row * DM + h * 128 + 2 * F.lane) = pk2(v.x * rs * g0 * siluf(bflo(zw)), v.y * rs * g1 * siluf(bfhi(zw)));
    }
}
__device__ __forceinline__ void final_norm(Frame& F) {
    const int gw = blockIdx.x * NWAVES + F.wave, NGW = F.G * NWAVES;
    f32x4 gv[4];
#pragma unroll
    for (int j = 0; j < 4; ++j) gv[j] = *(const f32x4*)(F.in[I_FNORMG] + 4 * F.lane + 256 * j);
    for (int m = gw; m < MT; m += NGW) {
        GAS f32x4* yr = (GAS f32x4*)(F.out + (size_t)m * DM) + F.lane;
        f32x4 v[4]; float s = 0.f;
#pragma unroll
        for (int j = 0; j < 4; ++j) { v[j] = yr[64 * j]; s += (v[j].x * v[j].x + v[j].y * v[j].y) + (v[j].z * v[j].z + v[j].w * v[j].w); }
        const float rs = 1.f / sqrtf(wave_sum(s) * (1.f / DM) + NORM_EPS);
#pragma unroll
        for (int j = 0; j < 4; ++j) yr[64 * j] = v[j] * rs * gv[j];
    }
}


typedef float f32x16 __attribute__((ext_vector_type(16)));
typedef float f32x2_t __attribute__((ext_vector_type(2)));
typedef __bf16 bf16x2_t __attribute__((ext_vector_type(2)));
typedef unsigned v2u __attribute__((ext_vector_type(2)));
__device__ __forceinline__ unsigned cvtpk(float lo, float hi) { f32x2_t v = {lo, hi}; bf16x2_t b = __builtin_convertvector(v, bf16x2_t); return __builtin_bit_cast(unsigned, b); }
__device__ __forceinline__ int crow(int r, int hi) { return (r & 3) + 8 * (r >> 2) + 4 * hi; }
#define MFMA32(a, b, c) __builtin_amdgcn_mfma_f32_32x32x16_bf16((a), (b), (c), 0, 0, 0)
__device__ __forceinline__ bf16x8 pack8(const f32x16& x, int s) {
    v4u p; p.x = cvtpk(x[8 * s], x[8 * s + 1]); p.y = cvtpk(x[8 * s + 2], x[8 * s + 3]); p.z = cvtpk(x[8 * s + 4], x[8 * s + 5]); p.w = cvtpk(x[8 * s + 6], x[8 * s + 7]);
    return __builtin_bit_cast(bf16x8, p);
}
constexpr int CHK_BYTES = 57344, CHK_WF = 0, CHK_QF = 16384, CHK_AF = 32768, CHK_KF = 40960;
constexpr int NCHUNK = SEQ / 64, NUNIT = PB * 4 * NCHUNK;
constexpr int CP_ROWB = 272;
constexpr int CP_QB = 0, CP_KB = 17408, CP_VB = 34816, CP_AM = 52224, CP_GC = 68608, CP_BETA = 68864, CP_EG = 69120, CP_HALF = 69632;

__device__ __forceinline__ void chunk_prep_pair(Frame& F, int pair) {
    int lane_ = F.lane; asm volatile("" : "+v"(lane_));
    const int half = F.tid >> 8, ht = F.tid & 255, hw = F.wave & 3, lane = lane_;
    const int unit = pair * 2 + half;
    const int bh = unit >> 7, c = unit & (NCHUNK - 1), b = bh >> 2, h = bh & 3;
    const int row0 = b * SEQ + c * 64;
    LAS unsigned char* L = F.lds + half * CP_HALF;
    LAS float* AM = (LAS float*)(L + CP_AM); LAS float* GC = (LAS float*)(L + CP_GC); LAS float* BETA = (LAS float*)(L + CP_BETA); LAS float* EG = (LAS float*)(L + CP_EG);
    unsigned char* chk = F.ws + WS_CHK + (size_t)unit * CHK_BYTES;
    if (hw == 0) {
        float g = F.GB[(size_t)(row0 + lane) * 8 + h]; const float be = F.GB[(size_t)(row0 + lane) * 8 + 4 + h];
#pragma unroll
        for (int o = 1; o < 64; o <<= 1) { const float t = __shfl_up(g, o); if (lane >= o) g += t; }
        GC[lane] = g; BETA[lane] = be; EG[lane] = __expf(g);
        if (lane == 63) ((float*)(F.ws + WS_GL))[unit] = __expf(g);
    }
    {
        const float* cw = F.in[I_CONVW];
        float wq[4][2], wk[4][2], wv[4][2];
#pragma unroll
        for (int j = 0; j < 4; ++j) { const float2 a = *(const float2*)(cw + j * CONVCH + h * 128 + 2 * lane), bq = *(const float2*)(cw + j * CONVCH + 512 + h * 128 + 2 * lane), cq = *(const float2*)(cw + j * CONVCH + 1024 + h * 128 + 2 * lane);
            wq[j][0] = a.x; wq[j][1] = a.y; wk[j][0] = bq.x; wk[j][1] = bq.y; wv[j][0] = cq.x; wv[j][1] = cq.y; }
        float xq[3][2], xk[3][2], xv[3][2];
        const int tok0 = c * 64 + hw * 16;
#pragma unroll
        for (int j = 0; j < 3; ++j) { const int tp = tok0 - 3 + j; unsigned a = 0u, bq = 0u, cq = 0u;
            if (tp >= 0) { const bf16* pr = F.PROJ + (size_t)(b * SEQ + tp) * NPROJ + h * 128 + 2 * lane; a = *(const unsigned*)pr; bq = *(const unsigned*)(pr + 512); cq = *(const unsigned*)(pr + 1024); }
            xq[j][0] = bflo(a); xq[j][1] = bfhi(a); xk[j][0] = bflo(bq); xk[j][1] = bfhi(bq); xv[j][0] = bflo(cq); xv[j][1] = bfhi(cq); }
#pragma unroll 4
        for (int tt = 0; tt < 16; ++tt) {
            const int tl = hw * 16 + tt;
            const bf16* pr = F.PROJ + (size_t)(row0 + tl) * NPROJ + h * 128 + 2 * lane;
            const unsigned a = *(const unsigned*)pr, bq = *(const unsigned*)(pr + 512), cq = *(const unsigned*)(pr + 1024);
            const float nq0 = bflo(a), nq1 = bfhi(a), nk0 = bflo(bq), nk1 = bfhi(bq), nv0 = bflo(cq), nv1 = bfhi(cq);
            float yq0 = wq[0][0] * xq[0][0] + wq[1][0] * xq[1][0] + wq[2][0] * xq[2][0] + wq[3][0] * nq0, yq1 = wq[0][1] * xq[0][1] + wq[1][1] * xq[1][1] + wq[2][1] * xq[2][1] + wq[3][1] * nq1;
            float yk0 = wk[0][0] * xk[0][0] + wk[1][0] * xk[1][0] + wk[2][0] * xk[2][0] + wk[3][0] * nk0, yk1 = wk[0][1] * xk[0][1] + wk[1][1] * xk[1][1] + wk[2][1] * xk[2][1] + wk[3][1] * nk1;
            float yv0 = wv[0][0] * xv[0][0] + wv[1][0] * xv[1][0] + wv[2][0] * xv[2][0] + wv[3][0] * nv0, yv1 = wv[0][1] * xv[0][1] + wv[1][1] * xv[1][1] + wv[2][1] * xv[2][1] + wv[3][1] * nv1;
#pragma unroll
            for (int e = 0; e < 2; ++e) { xq[0][e] = xq[1][e]; xq[1][e] = xq[2][e]; xk[0][e] = xk[1][e]; xk[1][e] = xk[2][e]; xv[0][e] = xv[1][e]; xv[1][e] = xv[2][e]; }
            xq[2][0] = nq0; xq[2][1] = nq1; xk[2][0] = nk0; xk[2][1] = nk1; xv[2][0] = nv0; xv[2][1] = nv1;
            yq0 = siluf(yq0); yq1 = siluf(yq1); yk0 = siluf(yk0); yk1 = siluf(yk1); yv0 = siluf(yv0); yv1 = siluf(yv1);
            const float qn = (1.f / sqrtf(wave_sum(yq0 * yq0 + yq1 * yq1) + NORM_EPS)) * 0.08838834764831845f, kn = 1.f / sqrtf(wave_sum(yk0 * yk0 + yk1 * yk1) + NORM_EPS);
            *(LAS unsigned*)(L + CP_QB + tl * CP_ROWB + 4 * lane) = cvtpk(yq0 * qn, yq1 * qn);
            *(LAS unsigned*)(L + CP_KB + tl * CP_ROWB + 4 * lane) = cvtpk(yk0 * kn, yk1 * kn);
            *(LAS unsigned*)(L + CP_VB + tl * CP_ROWB + 4 * lane) = cvtpk(yv0, yv1);
        }
    }
    __syncthreads();
    {
        const int r = lane & 31, hh = lane >> 5;
        f32x16 zero; for (int i = 0; i < 16; ++i) zero[i] = 0.f;
        const int njobs = 2;
#pragma unroll
        for (int job = 0; job < njobs; ++job) {
            int ta, tb; bool isz = false;
            if (hw == 0 || hw == 2) { ta = job; tb = job; } else if (hw == 1) { ta = job == 0 ? 1 : 0; tb = job == 0 ? 0 : 1; isz = job == 1; } else { ta = job == 0 ? 0 : 1; tb = job == 0 ? 1 : 0; isz = job == 1; }
            f32x16 acc = zero;
            if (!isz) {
                const int srcB = (hw < 2) ? CP_KB : CP_QB;
#pragma unroll
                for (int ks = 0; ks < 8; ++ks) {
                    const bf16x8 fa = *(const LAS bf16x8*)(L + CP_KB + (32 * ta + r) * CP_ROWB + (16 * ks + 8 * hh) * 2);
                    const bf16x8 fb = *(const LAS bf16x8*)(L + srcB + (32 * tb + r) * CP_ROWB + (16 * ks + 8 * hh) * 2);
                    acc = MFMA32(fa, fb, acc);
                }
            }
            if (hw < 2) {
                const int j = 32 * tb + r; const float gj = GC[j];
#pragma unroll
                for (int q = 0; q < 16; ++q) { const int i = 32 * ta + crow(q, hh); const float v = (i > j) ? acc[q] * BETA[i] * __expf(GC[i] - gj) : 0.f; AM[i * 64 + j] = v; }
            } else {
                const int i = 32 * tb + r; const float gi = GC[i];
                f32x16 x;
#pragma unroll
                for (int q = 0; q < 16; ++q) { const int j = 32 * ta + crow(q, hh); x[q] = (i >= j) ? acc[q] * __expf(gi - GC[j]) : 0.f; }
#pragma unroll
                for (int s = 0; s < 2; ++s) *(bf16x8*)(chk + CHK_AF + ((tb * 4 + 2 * ta + s) * 64 + lane) * 16) = pack8(x, s);
            }
        }
    }
    {
        const float gl_last = GC[63];
#pragma unroll
        for (int rep = 0; rep < 4; ++rep) {
            const int item = rep * 256 + ht, fl = item & 63, fr = item >> 6, m = fr >> 3, ks = fr & 7, r = fl & 31, hh = fl >> 5;
            const int i = 32 * m + r, col = 32 * (ks >> 1) + 16 * (ks & 1) + 4 * hh; const float e = EG[i];
            const v2u lo = *(const LAS v2u*)(L + CP_QB + i * CP_ROWB + col * 2), hi = *(const LAS v2u*)(L + CP_QB + i * CP_ROWB + (col + 8) * 2);
            v4u o; o.x = cvtpk(bflo(lo.x) * e, bfhi(lo.x) * e); o.y = cvtpk(bflo(lo.y) * e, bfhi(lo.y) * e); o.z = cvtpk(bflo(hi.x) * e, bfhi(hi.x) * e); o.w = cvtpk(bflo(hi.y) * e, bfhi(hi.y) * e);
            *(v4u*)(chk + CHK_QF + (size_t)item * 16) = o;
        }
#pragma unroll
        for (int rep = 0; rep < 4; ++rep) {
            const int item = rep * 256 + ht, fl = item & 63, fr = item >> 6, mt = fr >> 2, ks = fr & 3, r = fl & 31, hh = fl >> 5;
            const int dk = 32 * mt + r, j0 = 32 * (ks >> 1) + 16 * (ks & 1) + 4 * hh;
            float v[8];
#pragma unroll
            for (int jj = 0; jj < 8; ++jj) { const int j = j0 + 8 * (jj >> 2) + (jj & 3); v[jj] = bf2f(*(const LAS bf16*)(L + CP_KB + j * CP_ROWB + dk * 2)) * __expf(gl_last - GC[j]); }
            v4u o; o.x = cvtpk(v[0], v[1]); o.y = cvtpk(v[2], v[3]); o.z = cvtpk(v[4], v[5]); o.w = cvtpk(v[6], v[7]);
            *(v4u*)(chk + CHK_KF + (size_t)item * 16) = o;
        }
    }
    float x[64];
    {
        const int cc = ht & 127; const int src = (ht < 128) ? CP_VB : CP_KB;
#pragma unroll
        for (int i = 0; i < 64; ++i) { const float sc = (ht < 128) ? BETA[i] : BETA[i] * EG[i]; x[i] = bf2f(*(const LAS bf16*)(L + src + i * CP_ROWB + cc * 2)) * sc; }
    }
    __syncthreads();
#pragma unroll
    for (int i = 1; i < 64; ++i) {
        float acc0 = 0.f, acc1 = 0.f;
#pragma unroll
        for (int j4 = 0; j4 < (i + 3) / 4; ++j4) {
            const f32x4 a = *(const LAS f32x4*)(AM + i * 64 + 4 * j4);
            acc0 += a.x * x[4 * j4] + a.z * x[4 * j4 + 2]; acc1 += a.y * x[4 * j4 + 1] + a.w * x[4 * j4 + 3];
        }
        x[i] -= acc0 + acc1;
    }
    if (ht < 128) {
        v4u* dst = (v4u*)(F.ws + WS_UT + ((size_t)unit * 128 + ht) * 128);
#pragma unroll
        for (int mh = 0; mh < 4; ++mh) { const int m = mh >> 1, hh = mh & 1;
#pragma unroll
            for (int p = 0; p < 2; ++p) { v4u o;
                o.x = cvtpk(x[32 * m + crow(8 * p + 0, hh)], x[32 * m + crow(8 * p + 1, hh)]); o.y = cvtpk(x[32 * m + crow(8 * p + 2, hh)], x[32 * m + crow(8 * p + 3, hh)]);
                o.z = cvtpk(x[32 * m + crow(8 * p + 4, hh)], x[32 * m + crow(8 * p + 5, hh)]); o.w = cvtpk(x[32 * m + crow(8 * p + 6, hh)], x[32 * m + crow(8 * p + 7, hh)]);
                dst[mh * 2 + p] = o; } }
    } else {
        const int cc = ht - 128;
#pragma unroll
        for (int i = 0; i < 64; ++i) *(LAS bf16*)(L + CP_QB + i * CP_ROWB + cc * 2) = (bf16)(cvtpk(x[i], 0.f) & 0xffffu);
    }
    __syncthreads();
#pragma unroll
    for (int rep = 0; rep < 4; ++rep) {
        const int item = rep * 256 + ht, fl = item & 63, fr = item >> 6, m = fr >> 3, ks = fr & 7, r = fl & 31, hh = fl >> 5;
        const int i = 32 * m + r, col = 32 * (ks >> 1) + 16 * (ks & 1) + 4 * hh;
        const v2u lo = *(const LAS v2u*)(L + CP_QB + i * CP_ROWB + col * 2), hi = *(const LAS v2u*)(L + CP_QB + i * CP_ROWB + (col + 8) * 2);
        v4u o; o.x = lo.x; o.y = lo.y; o.z = hi.x; o.w = hi.y;
        *(v4u*)(chk + CHK_WF + (size_t)item * 16) = o;
    }
    __syncthreads();
}

__device__ __forceinline__ void dn_scan_unit(Frame& F, int bh) {
    int lane_ = threadIdx.x & 63; asm volatile("" : "+v"(lane_));
    const int lane = lane_, wave = F.wave, r = lane & 31, hh = lane >> 5;
    const int b = bh >> 2, h = bh & 3;
    const unsigned char* chk0 = F.ws + WS_CHK + (size_t)bh * NCHUNK * CHK_BYTES;
#define SCAN_BAR() do { asm volatile("s_waitcnt lgkmcnt(0)" ::: "memory"); __builtin_amdgcn_s_barrier(); asm volatile("" ::: "memory"); } while (0)
    if (wave >= 4) {
        const int lt = F.tid - 256;
        v4u ra[14], rb[14];
#pragma unroll
        for (int i = 0; i < 14; ++i) ra[i] = *(const v4u*)(chk0 + (size_t)(i * 256 + lt) * 16);
#pragma unroll
        for (int i = 0; i < 14; ++i) rb[i] = *(const v4u*)(chk0 + CHK_BYTES + (size_t)(i * 256 + lt) * 16);
#pragma unroll
        for (int i = 0; i < 14; ++i) *(LAS v4u*)(F.lds + (i * 256 + lt) * 16) = ra[i];
        SCAN_BAR();
        if (2 < NCHUNK) {
#pragma unroll
            for (int i = 0; i < 14; ++i) ra[i] = *(const v4u*)(chk0 + (size_t)2 * CHK_BYTES + (size_t)(i * 256 + lt) * 16);
        }
        for (int c = 0; c < NCHUNK; c += 2) {
#pragma unroll
            for (int i = 0; i < 14; ++i) *(LAS v4u*)(F.lds + CHK_BYTES + (i * 256 + lt) * 16) = rb[i];
            if (c + 3 < NCHUNK) {
#pragma unroll
                for (int i = 0; i < 14; ++i) rb[i] = *(const v4u*)(chk0 + (size_t)(c + 3) * CHK_BYTES + (size_t)(i * 256 + lt) * 16);
            }
            SCAN_BAR();
            if (c + 2 < NCHUNK) {
#pragma unroll
                for (int i = 0; i < 14; ++i) *(LAS v4u*)(F.lds + (i * 256 + lt) * 16) = ra[i];
            }
            if (c + 4 < NCHUNK) {
#pragma unroll
                for (int i = 0; i < 14; ++i) ra[i] = *(const v4u*)(chk0 + (size_t)(c + 4) * CHK_BYTES + (size_t)(i * 256 + lt) * 16);
            }
            SCAN_BAR();
        }
    } else {
        const int n0 = wave * 32;
        f32x16 S[4];
#pragma unroll
        for (int mt = 0; mt < 4; ++mt)
#pragma unroll
            for (int i = 0; i < 16; ++i) S[mt][i] = 0.f;
        const unsigned char* ut0 = F.ws + WS_UT + ((size_t)bh * NCHUNK * 128 + n0 + r) * 128 + hh * 32;
        const float* gl0 = (const float*)(F.ws + WS_GL) + bh * NCHUNK;
        v4u un[4];
#pragma unroll
        for (int m = 0; m < 2; ++m) { un[2 * m] = *(const v4u*)(ut0 + m * 64); un[2 * m + 1] = *(const v4u*)(ut0 + m * 64 + 16); }
        SCAN_BAR();
        for (int c = 0; c < NCHUNK; ++c) {
            LAS unsigned char* slot = F.lds + (c & 1) * CHK_BYTES;
            const float gl = gl0[c];
            f32x16 ws[2], qs[2];
#pragma unroll
            for (int m = 0; m < 2; ++m)
#pragma unroll
                for (int i = 0; i < 16; ++i) { ws[m][i] = 0.f; qs[m][i] = 0.f; }
#pragma unroll
            for (int ks = 0; ks < 8; ++ks) {
                const bf16x8 bS = pack8(S[ks >> 1], ks & 1);
#pragma unroll
                for (int m = 0; m < 2; ++m) {
                    const bf16x8 aw = *(const LAS bf16x8*)(slot + CHK_WF + ((m * 8 + ks) * 64 + lane) * 16);
                    const bf16x8 aq = *(const LAS bf16x8*)(slot + CHK_QF + ((m * 8 + ks) * 64 + lane) * 16);
                    ws[m] = MFMA32(aw, bS, ws[m]); qs[m] = MFMA32(aq, bS, qs[m]);
                }
            }
#pragma unroll
            for (int m = 0; m < 2; ++m) {
                const v4u u0 = un[2 * m], u1 = un[2 * m + 1];
                ws[m][0] = bflo(u0.x) - ws[m][0]; ws[m][1] = bfhi(u0.x) - ws[m][1]; ws[m][2] = bflo(u0.y) - ws[m][2]; ws[m][3] = bfhi(u0.y) - ws[m][3];
                ws[m][4] = bflo(u0.z) - ws[m][4]; ws[m][5] = bfhi(u0.z) - ws[m][5]; ws[m][6] = bflo(u0.w) - ws[m][6]; ws[m][7] = bfhi(u0.w) - ws[m][7];
                ws[m][8] = bflo(u1.x) - ws[m][8]; ws[m][9] = bfhi(u1.x) - ws[m][9]; ws[m][10] = bflo(u1.y) - ws[m][10]; ws[m][11] = bfhi(u1.y) - ws[m][11];
                ws[m][12] = bflo(u1.z) - ws[m][12]; ws[m][13] = bfhi(u1.z) - ws[m][13]; ws[m][14] = bflo(u1.w) - ws[m][14]; ws[m][15] = bfhi(u1.w) - ws[m][15];
            }
            if (c + 1 < NCHUNK) {
#pragma unroll
                for (int m = 0; m < 2; ++m) { un[2 * m] = *(const v4u*)(ut0 + (size_t)(c + 1) * 16384 + m * 64); un[2 * m + 1] = *(const v4u*)(ut0 + (size_t)(c + 1) * 16384 + m * 64 + 16); }
            }
            bf16x8 vb[4];
#pragma unroll
            for (int k = 0; k < 4; ++k) vb[k] = pack8(ws[k >> 1], k & 1);
#pragma unroll
            for (int k = 0; k < 4; ++k)
#pragma unroll
                for (int m = 0; m < 2; ++m) { const bf16x8 aa = *(const LAS bf16x8*)(slot + CHK_AF + ((m * 4 + k) * 64 + lane) * 16); qs[m] = MFMA32(aa, vb[k], qs[m]); }
            {
                float* orow = F.OA + (size_t)(b * SEQ + c * 64 + 4 * hh) * 512 + h * 128 + n0 + r;
                asm volatile("" : "+v"(orow));
#pragma unroll
                for (int m = 0; m < 2; ++m)
#pragma unroll
                    for (int i = 0; i < 16; ++i) orow[(32 * m + (i & 3) + 8 * (i >> 2)) * 512] = qs[m][i];
            }
#pragma unroll
            for (int mt = 0; mt < 4; ++mt) {
                S[mt] = S[mt] * gl;
#pragma unroll
                for (int k = 0; k < 4; ++k) { const bf16x8 ak = *(const LAS bf16x8*)(slot + CHK_KF + ((mt * 4 + k) * 64 + lane) * 16); S[mt] = MFMA32(ak, vb[k], S[mt]); }
            }
            SCAN_BAR();
        }
        float* so = F.out + O_DELTAP + (size_t)bh * 16384 + (4 * hh) * 128 + n0 + r;
#pragma unroll
        for (int mt = 0; mt < 4; ++mt)
#pragma unroll
            for (int i = 0; i < 16; ++i) so[(32 * mt + (i & 3) + 8 * (i >> 2)) * 128] = S[mt][i];
    }
#undef SCAN_BAR
    __syncthreads();
}


typedef short s16x4 __attribute__((ext_vector_type(4)));
typedef short v4i16_t __attribute__((ext_vector_type(4)));
__device__ __forceinline__ s16x4 vtr(const LAS unsigned char* p) { return __builtin_bit_cast(s16x4, __builtin_amdgcn_ds_read_tr16_b64_v4i16((LAS v4i16_t*)p)); }
constexpr int AT_VROW = 144, AT_VSLOT = 32 * AT_VROW, AT_WAVE_LDS = 2 * AT_VSLOT;
constexpr int AT_NTILE = 33;
constexpr float AT_C2 = 0.125f * 1.4426950408889634f;
__device__ __forceinline__ void at_tile_params(int ti, int& dsh, int& e0) {
    if (ti < 5) { dsh = 4; e0 = -128 + 32 * (4 - ti); } else if (ti < 13) { dsh = 2; e0 = -128 + 32 * (ti - 5); } else { dsh = 0; e0 = -128 + 32 * (ti - 13); }
}
__device__ __forceinline__ void attn_prompt_unit(Frame& F, int wu, LAS unsigned char* vl) {
    int lane_ = threadIdx.x & 63; asm volatile("" : "+v"(lane_));
    const int lane = lane_, r = lane & 31, hh = lane >> 5;
    const int rr = wu & 15, blk = (wu >> 4) & 15, bh = wu >> 8, b = bh >> 3, h = bh & 7;
    const int base = blk * 512 + rr, qpos = base + 16 * r;
    const bf16* Pb = F.PROJ + (size_t)b * SEQ * NPROJ + h * 64;
    bf16x8 qf[4];
#pragma unroll
    for (int ks = 0; ks < 4; ++ks) qf[ks] = *(const bf16x8*)(Pb + (size_t)qpos * NPROJ + PC_QB + 16 * ks + 8 * hh);
    f32x16 O[2];
#pragma unroll
    for (int i = 0; i < 16; ++i) { O[0][i] = 0.f; O[1][i] = 0.f; }
    float m = -INFINITY, l = 0.f;
    const int vkey = lane >> 3, vpiece = lane & 7;
    const int troff = (4 * hh + ((lane & 15) >> 2)) * AT_VROW + (16 * ((lane >> 4) & 1) + 4 * (lane & 3)) * 2;
    bf16x8 kf[4]; v4u vn[4];
    {
        int dsh, e0; at_tile_params(0, dsh, e0);
        int pk = base + ((e0 + r) << dsh); pk = pk < 0 ? 0 : (pk > SEQ - 1 ? SEQ - 1 : pk);
#pragma unroll
        for (int ks = 0; ks < 4; ++ks) kf[ks] = *(const bf16x8*)(Pb + (size_t)pk * NPROJ + PC_KB + 16 * ks + 8 * hh);
#pragma unroll
        for (int it = 0; it < 4; ++it) { int pv = base + ((e0 + vkey + 8 * it) << dsh); pv = pv < 0 ? 0 : (pv > SEQ - 1 ? SEQ - 1 : pv);
            vn[it] = *(const v4u*)(Pb + (size_t)pv * NPROJ + PC_VB + vpiece * 8); }
#pragma unroll
        for (int it = 0; it < 4; ++it) *(LAS v4u*)(vl + (vkey + 8 * it) * AT_VROW + vpiece * 16) = vn[it];
    }
    for (int ti = 0; ti < AT_NTILE; ++ti) {
        int dsh, e0; at_tile_params(ti, dsh, e0);
        bf16x8 kn[4];
        if (ti + 1 < AT_NTILE) {
            int dsh1, e01; at_tile_params(ti + 1, dsh1, e01);
            int pk = base + ((e01 + r) << dsh1); pk = pk < 0 ? 0 : (pk > SEQ - 1 ? SEQ - 1 : pk);
#pragma unroll
            for (int ks = 0; ks < 4; ++ks) kn[ks] = *(const bf16x8*)(Pb + (size_t)pk * NPROJ + PC_KB + 16 * ks + 8 * hh);
#pragma unroll
            for (int it = 0; it < 4; ++it) { int pv = base + ((e01 + vkey + 8 * it) << dsh1); pv = pv < 0 ? 0 : (pv > SEQ - 1 ? SEQ - 1 : pv);
                vn[it] = *(const v4u*)(Pb + (size_t)pv * NPROJ + PC_VB + vpiece * 8); }
        }
        f32x16 st;
#pragma unroll
        for (int i = 0; i < 16; ++i) st[i] = 0.f;
#pragma unroll
        for (int ks = 0; ks < 4; ++ks) st = MFMA32(kf[ks], qf[ks], st);
        const int X = ((16 >> dsh) * r) - e0;
        int lo = X - 128; const int emin = -(base >> dsh) - e0; lo = lo > emin ? lo : emin;
        int hi = X; lo -= 4 * hh; hi -= 4 * hh;
        if (hi < lo) { lo = 1000; hi = 1000; }
        const unsigned range = (unsigned)(hi - lo);
        float mt = -INFINITY;
#pragma unroll
        for (int i = 0; i < 16; ++i) { const int c = (i & 3) + 8 * (i >> 2); const bool ok = (unsigned)(c - lo) <= range; st[i] = ok ? st[i] * AT_C2 : -INFINITY; mt = fmaxf(mt, st[i]); }
        mt = fmaxf(mt, __shfl_xor(mt, 32));
        const float mn = fmaxf(m, mt);
        const float alpha = __builtin_amdgcn_exp2f(m - mn);
        float ps = 0.f;
#pragma unroll
        for (int i = 0; i < 16; ++i) { st[i] = __builtin_amdgcn_exp2f(st[i] - mn); ps += st[i]; }
        l = l * alpha + ps; m = mn;
        if (__any(alpha != 1.f)) {
#pragma unroll
            for (int i = 0; i < 16; ++i) { O[0][i] *= alpha; O[1][i] *= alpha; }
        }
        const LAS unsigned char* vs = vl + (ti & 1) * AT_VSLOT + troff;
#pragma unroll
        for (int s = 0; s < 2; ++s) {
            const bf16x8 pb = pack8(st, s);
#pragma unroll
            for (int dt = 0; dt < 2; ++dt) {
                const s16x4 a0 = vtr(vs + (16 * s) * AT_VROW + dt * 64), a1 = vtr(vs + (16 * s + 8) * AT_VROW + dt * 64);
                const bf16x8 va = (bf16x8){a0[0], a0[1], a0[2], a0[3], a1[0], a1[1], a1[2], a1[3]};
                O[dt] = MFMA32(va, pb, O[dt]);
            }
        }
        if (ti + 1 < AT_NTILE) {
#pragma unroll
            for (int it = 0; it < 4; ++it) *(LAS v4u*)(vl + ((ti + 1) & 1) * AT_VSLOT + (vkey + 8 * it) * AT_VROW + vpiece * 16) = vn[it];
#pragma unroll
            for (int ks = 0; ks < 4; ++ks) kf[ks] = kn[ks];
        }
    }
    l += __shfl_xor(l, 32);
    const float il = 1.f / l;
    const size_t row = (size_t)b * SEQ + qpos;
    const bf16* zp = F.PROJ + row * NPROJ + PC_ZB + h * 64 + 4 * hh;
    bf16* op = F.MIX + row * DM + 512 + h * 64 + 4 * hh;
#pragma unroll
    for (int dt = 0; dt < 2; ++dt)
#pragma unroll
        for (int g = 0; g < 4; ++g) {
            const v2u z = *(const v2u*)(zp + 32 * dt + 8 * g);
            v2u o; o.x = cvtpk(O[dt][4 * g] * il * siluf(bflo(z.x)), O[dt][4 * g + 1] * il * siluf(bfhi(z.x))); o.y = cvtpk(O[dt][4 * g + 2] * il * siluf(bflo(z.y)), O[dt][4 * g + 3] * il * siluf(bfhi(z.y)));
            *(v2u*)(op + 32 * dt + 8 * g) = o;
        }
}
__device__ __forceinline__ float wave_max(float v) {
#pragma unroll
    for (int o = 1; o < 64; o <<= 1) v = fmaxf(v, __shfl_xor(v, o));
    return v;
}
__device__ __forceinline__ void attn_decode_item(Frame& F, int item) {
    int lane_ = threadIdx.x & 63; asm volatile("" : "+v"(lane_));
    const int lane = lane_, t = item & 3, h = (item >> 2) & 7, b = item >> 5;
    const size_t row = (size_t)NP + b * ST + t;
    float q[64]; ld_bf16x64(F.PROJ + row * NPROJ + PC_QB + h * 64, q);
    float s[7];
#pragma unroll
    for (int p = 0; p < 7; ++p) {
        const int k = lane + 64 * p, br = k / 129, j = k - 129 * br, d = br == 0 ? 1 : (br == 1 ? 4 : 16), idx = LBUF + t - d * j;
        float v = -INFINITY;
        if (k < 387) { if (idx >= LBUF) v = dot_bf16row(F.PROJ + ((size_t)NP + b * ST + (idx - LBUF)) * NPROJ + PC_KB + h * 64, q); else v = dot_f32row(F.in[I_CK] + ((size_t)b * LBUF + idx) * 512 + h * 64, q); v *= 0.125f; }
        s[p] = v;
    }
    float mx = s[0];
#pragma unroll
    for (int p = 1; p < 7; ++p) mx = fmaxf(mx, s[p]);
    mx = wave_max(mx);
    float o[64];
#pragma unroll
    for (int i = 0; i < 64; ++i) o[i] = 0.f;
    float ls = 0.f;
#pragma unroll
    for (int p = 0; p < 7; ++p) {
        const int k = lane + 64 * p, br = k / 129, j = k - 129 * br, d = br == 0 ? 1 : (br == 1 ? 4 : 16), idx = LBUF + t - d * j;
        if (k < 387) { const float pw = __expf(s[p] - mx); ls += pw;
            if (idx >= LBUF) axpy_bf16row(F.PROJ + ((size_t)NP + b * ST + (idx - LBUF)) * NPROJ + PC_VB + h * 64, pw, 1.f, o); else axpy_f32row(F.in[I_CV] + ((size_t)b * LBUF + idx) * 512 + h * 64, pw, 1.f, o); }
    }
    ls = wave_sum(ls);
    const float il = 1.f / ls;
    float mine = 0.f;
#pragma unroll
    for (int i = 0; i < 64; ++i) { const float tot = wave_sum(o[i]); mine = (lane == i) ? tot : mine; }
    const float z = bf2f(F.PROJ[row * NPROJ + PC_ZB + h * 64 + lane]);
    F.MIX[row * DM + 512 + h * 64 + lane] = (bf16)(cvtpk(mine * il * siluf(z), 0.f) & 0xffffu);
}

#ifndef MK_N_LAUNCHES
#define MK_N_LAUNCHES 1
#endif
constexpr int N_PHASES = 7, N_LAUNCHES = MK_N_LAUNCHES;
__global__ void __launch_bounds__(NTHR, 2) hymba_fwd(Args args) {
    extern __shared__ __attribute__((aligned(16))) unsigned char lds[];
    Frame F;
    F.lds = (LAS unsigned char*)lds;
    F.tid = threadIdx.x; F.lane = F.tid & 63; F.wave = __builtin_amdgcn_readfirstlane(F.tid >> 6); F.G = gridDim.x;
#pragma unroll
    for (int i = 0; i < 14; ++i) F.in[i] = args.in[i];
    F.out = args.out; F.ws = args.ws;
    F.WinT = (bf16*)(args.ws + WS_WIN); F.WoutT = (bf16*)(args.ws + WS_WOUT); F.XN = (bf16*)(args.ws + WS_XN); F.PROJ = (bf16*)(args.ws + WS_PROJ); F.MIX = (bf16*)(args.ws + WS_MIX);
    F.GB = (float*)(args.ws + WS_GB); F.OA = (float*)(args.ws + WS_OA);
    volatile LAS unsigned* MISC = (volatile LAS unsigned*)(F.lds + MISC_OFF);
    if (F.tid < 64) ((LAS unsigned*)(F.lds + MISC_OFF))[F.tid] = 0u;
    __syncthreads();
    unsigned* barw = (unsigned*)(args.ws + WS_CTL) + CW_BAR;
    XcdBarrier bar; bar.bar = barw; bar.x = 0; bar.st = nullptr;
    if (N_LAUNCHES == 1) bar = xcd_barrier_post(barw, MISC + 8);
    const int lo = args.ph_lo, hi = args.ph_hi;
#define IN(k) (lo <= (k) && (k) < hi)
#define BOTH(k) (IN(k) && IN((k) + 1))
#define GRID_BAR() do { if (N_LAUNCHES == 1) xcd_barrier(bar); } while (0)

    if (IN(0)) { p0_prologue(F); if (BOTH(0)) GRID_BAR(); }
    if (IN(1)) {
        gu32* ctlw = (gu32*)(args.ws + WS_CTL);
        if ((int)blockIdx.x < G1_GEMM_WGS) {
            pg8::Gemm g{F.XN, F.WinT, MT, NPROJ, DM}; pg8::StaticOrder S; S.init(MT, NPROJ, G1_GEMM_WGS, (int)blockIdx.x);
            pg8::EpiBf16 E{F.PROJ, NPROJ};
            pg8::gemm_phase<pg8::EpiBf16, pg8::StaticOrder, true, true>(F.lds, g, S, E);
            if (F.tid == 0) __hip_atomic_fetch_add(ctlw + CW_G1DONE, 1u, RLX_AGENT);
        } else copy_pull(F, MISC, ctlw + CW_QC, ctlw + CW_G1DONE, (unsigned)G1_GEMM_WGS);
        if (BOTH(1)) GRID_BAR();
    }
    if (IN(2)) {
        for (int p = blockIdx.x; p < NUNIT / 2; p += F.G) chunk_prep_pair(F, p);
        for (int u = 16 + blockIdx.x; u < 16 + SB * 4; u += F.G) dn_seq_unit(F, u);
        if (BOTH(2)) GRID_BAR();
    }
    if (IN(3)) {
        gu32* ctlw = (gu32*)(args.ws + WS_CTL);
        const bool copy_first = (int)blockIdx.x >= 16 && (int)blockIdx.x < 16 + P3_COPY_WGS;
        if (blockIdx.x < 16) dn_scan_unit(F, blockIdx.x);
        if (copy_first) copy_pull(F, MISC, ctlw + CW_QC, nullptr, 0u);
        {
            LAS unsigned char* vl = F.lds + F.wave * AT_WAVE_LDS;
            gu32* qhead = ctlw + CW_Q0;
            for (;;) {
                if (F.tid == 0) MISC[0] = __hip_atomic_fetch_add(qhead, 1u, RLX_AGENT);
                __syncthreads();
                const int unit = (int)MISC[0];
                __syncthreads();
                if (unit >= 1024 + 512) break;
                if (unit < 1024) attn_prompt_unit(F, unit * 8 + F.wave, vl); else attn_decode_item(F, (unit - 1024) * 8 + F.wave);
            }
        }
        if (!copy_first) copy_pull(F, MISC, ctlw + CW_QC, nullptr, 0u);
        small_outputs(F);
        if (BOTH(3)) GRID_BAR();
    }
    if (IN(4)) { mix_a_finish(F); if (BOTH(4)) GRID_BAR(); }
    if (IN(5)) {
        pg8::Gemm g{F.MIX, F.WoutT, MT, DM, DM}; pg8::StaticOrder S; S.init(MT, DM, F.G, (int)blockIdx.x);
        pg8::EpiResF32 E{F.in[I_XP], F.in[I_XS], NP, F.out, DM};
        pg8::gemm_phase<pg8::EpiResF32, pg8::StaticOrder, true, true>(F.lds, g, S, E);
        if (BOTH(5)) GRID_BAR();
    }
    if (IN(6)) { final_norm(F); }
#undef IN
#undef BOTH
}

extern "C" void kernel_launch(void* const* d_in, const int* in_sizes, int n_in, void* d_out, int out_size, void* d_ws, size_t ws_size, hipStream_t stream) {
    static int grid = 0;
    if (grid == 0) {
        if (n_in != 14 || (size_t)out_size != O_END || ws_size < WS_END) { fprintf(stderr, "kernel_launch: unexpected shapes (n_in %d, out %d, ws %zu); nothing launched\n", n_in, out_size, ws_size); grid = -1; return; }
        int dev = 0, cus = 0, per_cu = 0;
        if (hipGetDevice(&dev) != hipSuccess || hipDeviceGetAttribute(&cus, hipDeviceAttributeMultiprocessorCount, dev) != hipSuccess) { grid = -1; return; }
        if (hipFuncSetAttribute((const void*)hymba_fwd, hipFuncAttributeMaxDynamicSharedMemorySize, LDS_BYTES) != hipSuccess) { fprintf(stderr, "kernel_launch: hipFuncSetAttribute failed\n"); grid = -1; return; }
        if (hipOccupancyMaxActiveBlocksPerMultiprocessor(&per_cu, (const void*)hymba_fwd, NTHR, LDS_BYTES) != hipSuccess || per_cu < 1) fprintf(stderr, "kernel_launch: occupancy query says %d\n", per_cu);
        (void)hipGetLastError();
        grid = cus;
    }
    if (grid < 0) return;
    if (hipMemsetAsync((char*)d_ws + WS_CTL, 0, CTL_ZERO_BYTES, stream) != hipSuccess) return;
    Args a{};
    for (int i = 0; i < 14; ++i) a.in[i] = (const float*)d_in[i];
    a.out = (float*)d_out; a.ws = (unsigned char*)d_ws;
    if (N_LAUNCHES == 1) { a.ph_lo = 0; a.ph_hi = N_PHASES; hipLaunchKernelGGL(hymba_fwd, dim3(grid), dim3(NTHR), LDS_BYTES, stream, a); }
    else for (int li = 0; li < N_PHASES; ++li) { a.ph_lo = li; a.ph_hi = li + 1; hipLaunchKernelGGL(hymba_fwd, dim3(grid), dim3(NTHR), LDS_BYTES, stream, a); }
}
```
